# Optimizing an MI355X kernel written in HIP

```python
import math
import jax, jax.numpy as jnp
from jax import lax
import numpy as np


D_MODEL = 1024
BATCH = 16
SEQ = 2048
DEPTH = 2

GRID_W = 64
CTX_LEN = 256
N_GROUPS = 4
GROUP_W = D_MODEL // N_GROUPS
HEADS = 4
HEAD_DIM = GROUP_W // HEADS
CHUNK = 128
DIFF_QK = HEAD_DIM // 2
ROT_HALF = DIFF_QK // 2
ROPE_THETA = 10000.0
Q_BLOCK = 128
D_FF = 2816
EPS = 1e-6
G_AU, G_AV, G_BX, G_BB, G_BC, G_CF, G_DQ, G_DK, G_DV = range(9)
IN_COLS = 9 * GROUP_W
KV_COL0 = G_DK * GROUP_W

kernel_name = 'hybrid_parallel_head_dit_block'


def rmsnorm(x, g=None):
    xf = x.astype(jnp.float32)
    y = xf * lax.rsqrt(jnp.mean(xf * xf, axis=-1, keepdims=True) + EPS)
    if g is not None:
        y = y * g.astype(jnp.float32)
    return y.astype(x.dtype)


def adaln_params(cvec, w_ada, b_ada):
    m = jax.nn.silu(cvec) @ w_ada + b_ada
    return jnp.split(m, 6, axis=-1)


def modulate(h, shift, scale):
    return h * (1 + scale) + shift


def group(z, i):
    return z[..., i * GROUP_W:(i + 1) * GROUP_W]


def dwconv3(x, w):
    xp = jnp.pad(x, ((0, 0), (1, 1), (0, 0)))
    return xp[:, :-2] * w[0] + xp[:, 1:-1] * w[1] + xp[:, 2:] * w[2]


def mixer_a(z, ws, bs):
    B, N, _ = z.shape
    u = jax.nn.gelu(group(z, G_AU))
    v = rmsnorm(jax.nn.gelu(group(z, G_AV)).reshape(B, N, HEADS, HEAD_DIM))
    v = v.reshape(B, N // CHUNK, CHUNK, HEADS, HEAD_DIM)
    mixed = jnp.einsum('hpq,bcqhd->bcphd', ws, v) + bs.T[:, :, None]
    return u * mixed.reshape(B, N, GROUP_W)


def mixer_b(z, w):
    return group(z, G_BB) * dwconv3(group(z, G_BC) * group(z, G_BX), w)


def mixer_c(z):
    B, N, _ = z.shape
    f = group(z, G_CF).reshape(B, N, HEADS, HEAD_DIM).astype(jnp.float32)
    F = jnp.fft.fft2(f, axes=(1, 3), norm='ortho').real
    return F.astype(z.dtype).reshape(B, N, GROUP_W)


def apply_rope_2d(t, ang_r, ang_c):
    def rot(u, ang):
        cos = jnp.cos(ang)[None, :, None, None, :].astype(u.dtype)
        sin = jnp.sin(ang)[None, :, None, None, :].astype(u.dtype)
        u1, u2 = u[..., :ROT_HALF // 2], u[..., ROT_HALF // 2:]
        return jnp.concatenate([u1 * cos - u2 * sin, u2 * cos + u1 * sin], axis=-1)
    return jnp.concatenate([rot(t[..., :ROT_HALF], ang_r), rot(t[..., ROT_HALF:], ang_c)], axis=-1)


def diff_attend(q, k, v, lam):
    s = jnp.einsum('bqhmd,bkhmd->bhmqk', q, k).astype(jnp.float32) * (DIFF_QK ** -0.5)
    p = jax.nn.softmax(s, axis=-1)
    a = p[:, :, 0] - lam * p[:, :, 1]
    return jnp.einsum('bhqk,bkhd->bqhd', a.astype(v.dtype), v)


def diff_out(o, g, lam_init):
    B, N = o.shape[0], o.shape[1]
    return (rmsnorm(o, g) * (1 - lam_init)).reshape(B, N, GROUP_W)


def conv_ffn(h, w_up, conv_w, w_down):
    up = h @ w_up
    a, b = up[..., :D_FF], up[..., D_FF:]
    return (jax.nn.silu(dwconv3(a, conv_w)) * b) @ w_down


def trunk_layer(x, xc, c, c_ctx, ang_r, ang_c, layer_idx, ctx_out,
                w_ada, b_ada, g1, g2, w_in, gm_ws, gm_bs, sc_w,
                lq1, lk1, lq2, lk2, subln_g, w_out, w_up, ffn_conv, w_down):
    B, N, _ = x.shape
    L = xc.shape[1]
    sh1, sc1, gt1, sh2, sc2, gt2 = [m[:, None, :] for m in adaln_params(c, w_ada, b_ada)]
    shc1, scc1, gtc1, shc2, scc2, gtc2 = adaln_params(c_ctx, w_ada, b_ada)
    lam_init = 0.8 - 0.6 * math.exp(-0.3 * layer_idx)
    f32 = jnp.float32
    lam = (jnp.exp(jnp.sum(lq1.astype(f32) * lk1.astype(f32)))
           - jnp.exp(jnp.sum(lq2.astype(f32) * lk2.astype(f32))) + lam_init)

    h = modulate(rmsnorm(x, g1), sh1, sc1)
    hc = modulate(rmsnorm(xc, g1), shc1, scc1)
    z = h @ w_in
    zc_kv = hc @ w_in[:, KV_COL0:]
    kc = zc_kv[..., :GROUP_W].reshape(B, L, HEADS, 2, DIFF_QK)
    vc = zc_kv[..., GROUP_W:].reshape(B, L, HEADS, HEAD_DIM)

    q = apply_rope_2d(group(z, G_DQ).reshape(B, N, HEADS, 2, DIFF_QK), ang_r, ang_c)
    k = apply_rope_2d(group(z, G_DK).reshape(B, N, HEADS, 2, DIFF_QK), ang_r, ang_c)
    v = group(z, G_DV).reshape(B, N, HEADS, HEAD_DIM)
    k_all = jnp.concatenate([kc, k], axis=1)
    v_all = jnp.concatenate([vc, v], axis=1)
    qb = q.reshape(B, N // Q_BLOCK, Q_BLOCK, HEADS, 2, DIFF_QK).swapaxes(0, 1)
    o = lax.map(lambda qi: diff_attend(qi, k_all, v_all, lam), qb)
    o = o.swapaxes(0, 1).reshape(B, N, HEADS, HEAD_DIM)

    mix = jnp.concatenate([mixer_a(z, gm_ws, gm_bs), mixer_b(z, sc_w), mixer_c(z),
                           diff_out(o, subln_g, lam_init)], axis=-1)
    x = x + gt1 * (mix @ w_out)
    x = x + gt2 * conv_ffn(modulate(rmsnorm(x, g2), sh2, sc2), w_up, ffn_conv, w_down)
    if not ctx_out:
        return x, None

    zc = hc @ w_in[:, :KV_COL0]
    qc = group(zc, G_DQ).reshape(B, L, HEADS, 2, DIFF_QK)
    oc = diff_attend(qc, kc, vc, lam)
    mixc = jnp.concatenate([mixer_a(zc, gm_ws, gm_bs), mixer_b(zc, sc_w), mixer_c(zc),
                            diff_out(oc, subln_g, lam_init)], axis=-1)
    xc = xc + gtc1 * (mixc @ w_out)
    xc = xc + gtc2 * conv_ffn(modulate(rmsnorm(xc, g2), shc2, scc2), w_up, ffn_conv, w_down)
    return x, xc


def setup_inputs(seed: int = 0) -> dict:
    key = jax.random.key(seed)
    ks = jax.random.split(key, 24)
    D = D_MODEL

    def nrm(k, shape, scale):
        return jax.random.normal(k, shape, jnp.float32) * scale

    return {
        'x': nrm(ks[0], (BATCH, SEQ, D), 1.0),
        'c': nrm(ks[1], (BATCH, D), 1.0),
        'ctx': nrm(ks[2], (BATCH, CTX_LEN, D), 1.0),
        'c_ctx': nrm(ks[3], (D,), 1.0),
        'w_ada': nrm(ks[4], (DEPTH, D, 6 * D), 0.5 * D ** -0.5),
        'b_ada': nrm(ks[5], (DEPTH, 6 * D), 0.02),
        'norm1_g': 1.0 + nrm(ks[6], (DEPTH, D), 0.02),
        'norm2_g': 1.0 + nrm(ks[7], (DEPTH, D), 0.02),
        'w_in': nrm(ks[8], (DEPTH, D, IN_COLS), D ** -0.5),
        'gmlp_ws': nrm(ks[9], (DEPTH, HEADS, CHUNK, CHUNK), CHUNK ** -0.5),
        'gmlp_bs': 1.0 + nrm(ks[10], (DEPTH, HEADS, CHUNK), 0.02),
        'sconv_w': nrm(ks[11], (DEPTH, 3, GROUP_W), 3 ** -0.5),
        'lambda_q1': nrm(ks[12], (DEPTH, DIFF_QK), 0.1),
        'lambda_k1': nrm(ks[13], (DEPTH, DIFF_QK), 0.1),
        'lambda_q2': nrm(ks[14], (DEPTH, DIFF_QK), 0.1),
        'lambda_k2': nrm(ks[15], (DEPTH, DIFF_QK), 0.1),
        'subln_g': 1.0 + nrm(ks[16], (DEPTH, HEAD_DIM), 0.02),
        'w_out': nrm(ks[17], (DEPTH, D, D), D ** -0.5),
        'ffn_w_up': nrm(ks[18], (DEPTH, D, 2 * D_FF), D ** -0.5),
        'ffn_conv_w': nrm(ks[19], (DEPTH, 3, D_FF), 3 ** -0.5),
        'ffn_w_down': nrm(ks[20], (DEPTH, D_FF, D), D_FF ** -0.5),
        'final_g': 1.0 + nrm(ks[21], (D,), 0.02),
    }


def reference(x, c, ctx, c_ctx, w_ada, b_ada, norm1_g, norm2_g, w_in, gmlp_ws, gmlp_bs,
              sconv_w, lambda_q1, lambda_k1, lambda_q2, lambda_k2, subln_g, w_out,
              ffn_w_up, ffn_conv_w, ffn_w_down, final_g):
    N = x.shape[1]
    ROWS = N // GRID_W
    row = jnp.broadcast_to(jnp.arange(ROWS, dtype=jnp.float32)[:, None], (ROWS, GRID_W)).reshape(-1)
    col = jnp.broadcast_to(jnp.arange(GRID_W, dtype=jnp.float32)[None, :], (ROWS, GRID_W)).reshape(-1)
    inv_freq = ROPE_THETA ** (-jnp.arange(0, ROT_HALF, 2, dtype=jnp.float32) / ROT_HALF)
    ang_r = row[:, None] * inv_freq
    ang_c = col[:, None] * inv_freq
    xc = ctx
    for l in range(DEPTH):
        x, xc = trunk_layer(
            x, xc, c, c_ctx, ang_r, ang_c, l, l < DEPTH - 1,
            w_ada[l], b_ada[l], norm1_g[l], norm2_g[l], w_in[l], gmlp_ws[l], gmlp_bs[l],
            sconv_w[l], lambda_q1[l], lambda_k1[l], lambda_q2[l], lambda_k2[l], subln_g[l],
            w_out[l], ffn_w_up[l], ffn_conv_w[l], ffn_w_down[l])
    return rmsnorm(x, final_g)
```

```cpp
#include <hip/hip_runtime.h>
#include <hip/hip_cooperative_groups.h>
#include <cstdio>
#include <cstdint>
namespace cg = cooperative_groups;

typedef _Float16 h16;
typedef h16 h16x8 __attribute__((ext_vector_type(8)));
typedef h16 h16x4 __attribute__((ext_vector_type(4)));
typedef float f32x16 __attribute__((ext_vector_type(16)));
typedef float f32x4 __attribute__((ext_vector_type(4)));
typedef unsigned u32x4 __attribute__((ext_vector_type(4)));

#define DM 1024
#define NBATCH 16
#define SEQ 2048
#define LCTX 256
#define NLAT 32768
#define NCTX 4096
#define NTOK 36864
#define ZC 2560
#define DFF 2816
#define NKEY 2304
#define EPS 1e-6f
#define NTHREADS 512
#define NWAVES 8
#define LDS_BYTES 131072
#define LDS_STAGE 65536

struct Params {
  const float *x, *c, *ctx, *c_ctx, *w_ada, *b_ada, *w_in, *gm_ws;
  const float *lq1, *lk1, *lq2, *lk2, *w_out, *w_up, *w_down;
  const float *g1_in, *g2_in, *gm_bs_in, *sc_w_in, *subln_in, *ffn_conv_in, *final_g_in;
  const float *g1, *g2, *gm_bs, *sc_w, *subln, *ffn_conv, *final_g;
  float* out;
  float* mod; float* lam; float* rope; float* Xc; const h16* zero; unsigned* bar;
  h16 *WinT, *WoutT, *WupT, *WdownT, *Ws16, *Fn, *Fc;
  h16 *H16;
  h16 *U16, *VTl, *VTc, *ZB, *GTl, *GTc, *Q16, *K16, *VT16, *ACT;
};
struct KArgs { const float* in[22]; float* out; unsigned char* ws; };

constexpr size_t al256(size_t x) { return (x + 255) & ~(size_t)255; }
constexpr size_t OFF_MOD = 0;
constexpr size_t OFF_LAM = OFF_MOD + al256((size_t)2 * 17 * 6144 * 4);
constexpr size_t OFF_ROPE = OFF_LAM + 256;
constexpr size_t OFF_SMALL = OFF_ROPE + al256((size_t)2048 * 32 * 4);
constexpr size_t OFF_ZERO = OFF_SMALL + al256((size_t)32768 * 4);
constexpr size_t OFF_BAR = OFF_ZERO + 8192;
constexpr size_t OFF_XC = OFF_BAR + 1024;
constexpr size_t OFF_WINT = OFF_XC + al256((size_t)NCTX * 1024 * 4);
constexpr size_t OFF_WOUTT = OFF_WINT + al256((size_t)2 * ZC * 1024 * 2);
constexpr size_t OFF_WUPT = OFF_WOUTT + al256((size_t)2 * 1024 * 1024 * 2);
constexpr size_t OFF_WDOWNT = OFF_WUPT + al256((size_t)2 * 5632 * 1024 * 2);
constexpr size_t OFF_WS16 = OFF_WDOWNT + al256((size_t)2 * 1024 * DFF * 2);
constexpr size_t OFF_FN = OFF_WS16 + al256((size_t)2 * 4 * 128 * 128 * 2);
constexpr size_t OFF_FC = OFF_FN + al256((size_t)2048 * 4096 * 2);
constexpr size_t OFF_H16 = OFF_FC + al256((size_t)256 * 512 * 2);
constexpr size_t OFF_ACT = OFF_H16 + al256((size_t)NTOK * 1024 * 2);
constexpr size_t OFF_END = OFF_ACT + al256((size_t)NTOK * DFF * 2);
constexpr size_t OFF_U16 = OFF_ACT;
constexpr size_t OFF_VTL = OFF_U16 + al256((size_t)NTOK * 256 * 2);
constexpr size_t OFF_VTC = OFF_VTL + al256((size_t)4 * 1024 * 2048 * 2);
constexpr size_t OFF_ZB = OFF_VTC + al256((size_t)4 * 1024 * 256 * 2);
constexpr size_t OFF_GTL = OFF_ZB + al256((size_t)NTOK * 768 * 2);
constexpr size_t OFF_GTC = OFF_GTL + al256((size_t)4096 * 4096 * 2);
constexpr size_t OFF_Q16 = OFF_GTC + al256((size_t)4096 * 512 * 2);
constexpr size_t OFF_K16 = OFF_Q16 + al256((size_t)NTOK * 256 * 2);
constexpr size_t OFF_VT16 = OFF_K16 + al256((size_t)NBATCH * NKEY * 256 * 2);
constexpr size_t OFF_REGION_END = OFF_VT16 + al256((size_t)NBATCH * 256 * NKEY * 2);
static_assert(OFF_REGION_END <= OFF_END, "P1 outputs overflow the ACT region");
#define SM_G1 0
#define SM_G2 2048
#define SM_GMBS 4096
#define SM_SCW 5120
#define SM_SUBLN 6656
#define SM_FFNCONV 6784
#define SM_FINALG 23680
#define SM_TOTAL 24704

__device__ __forceinline__ Params make_params(const KArgs& a) {
  Params p;
  p.x = a.in[0]; p.c = a.in[1]; p.ctx = a.in[2]; p.c_ctx = a.in[3]; p.w_ada = a.in[4]; p.b_ada = a.in[5];
  p.g1_in = a.in[6]; p.g2_in = a.in[7]; p.w_in = a.in[8]; p.gm_ws = a.in[9]; p.gm_bs_in = a.in[10]; p.sc_w_in = a.in[11];
  p.lq1 = a.in[12]; p.lk1 = a.in[13]; p.lq2 = a.in[14]; p.lk2 = a.in[15]; p.subln_in = a.in[16]; p.w_out = a.in[17];
  p.w_up = a.in[18]; p.ffn_conv_in = a.in[19]; p.w_down = a.in[20]; p.final_g_in = a.in[21];
  p.out = a.out;
  unsigned char* w = a.ws;
  const float* sm = (const float*)(w + OFF_SMALL);
  p.g1 = sm + SM_G1; p.g2 = sm + SM_G2; p.gm_bs = sm + SM_GMBS; p.sc_w = sm + SM_SCW; p.subln = sm + SM_SUBLN;
  p.ffn_conv = sm + SM_FFNCONV; p.final_g = sm + SM_FINALG;
  p.mod = (float*)(w + OFF_MOD); p.lam = (float*)(w + OFF_LAM); p.rope = (float*)(w + OFF_ROPE); p.Xc = (float*)(w + OFF_XC); p.zero = (const h16*)(w + OFF_ZERO); p.bar = (unsigned*)(w + OFF_BAR);
  p.WinT = (h16*)(w + OFF_WINT); p.WoutT = (h16*)(w + OFF_WOUTT); p.WupT = (h16*)(w + OFF_WUPT); p.WdownT = (h16*)(w + OFF_WDOWNT);
  p.Ws16 = (h16*)(w + OFF_WS16); p.Fn = (h16*)(w + OFF_FN); p.Fc = (h16*)(w + OFF_FC); p.H16 = (h16*)(w + OFF_H16);
  p.ACT = (h16*)(w + OFF_ACT); p.U16 = (h16*)(w + OFF_U16); p.VTl = (h16*)(w + OFF_VTL); p.VTc = (h16*)(w + OFF_VTC);
  p.ZB = (h16*)(w + OFF_ZB); p.GTl = (h16*)(w + OFF_GTL); p.GTc = (h16*)(w + OFF_GTC); p.Q16 = (h16*)(w + OFF_Q16);
  p.K16 = (h16*)(w + OFF_K16); p.VT16 = (h16*)(w + OFF_VT16);
  return p;
}

__device__ __forceinline__ float gelu_f(float x) {
  const float u = 0.7978845608028654f * (x + 0.044715f * x * x * x);
  return x * __builtin_amdgcn_rcpf(1.f + __expf(-2.f * u));
}
__device__ __forceinline__ float silu_f(float x) { return x * __builtin_amdgcn_rcpf(1.f + __expf(-x)); }
__device__ __forceinline__ h16x4 pack4(float a, float b, float c, float d) {
  h16x4 r; r[0] = (h16)a; r[1] = (h16)b; r[2] = (h16)c; r[3] = (h16)d; return r;
}
#define LAS __attribute__((address_space(3)))
__device__ __forceinline__ int opaque_tid() { int t = threadIdx.x; asm volatile("" : "+v"(t)); return t; }
__device__ __forceinline__ float ldvol(const float* p) { return *(const volatile float*)p; }

template <typename ARowFn>
__device__ __forceinline__ void gemm256(f32x4 (&acc)[8][4], ARowFn arow, const h16* Bt, const int ldb, const int K,
                                        unsigned char* smem, const int tid) {
  const int lane = tid & 63, wid = tid >> 6, wm = wid >> 2, wn = wid & 3;
  const int l15 = lane & 15, g4 = lane >> 4;
  const int lr = tid >> 3, lc = tid & 7;
  const h16* ap[4]; const h16* bp[4];
#pragma unroll
  for (int i = 0; i < 4; ++i) {
    const int r = lr + 64 * i;
    const int gc = (lc ^ ((r >> 1) & 7)) * 8;
    ap[i] = arow(r) + gc;
    bp[i] = Bt + (size_t)r * ldb + gc;
  }
#pragma unroll
  for (int mi = 0; mi < 8; ++mi)
#pragma unroll
    for (int nj = 0; nj < 4; ++nj)
#pragma unroll
      for (int r = 0; r < 4; ++r) acc[mi][nj][r] = 0.f;
  const int nk = K >> 6;
  const int sw = (l15 >> 1) & 7;
  const int arow0 = (wm * 128 + l15) * 128, brow0 = (wn * 64 + l15) * 128;
  LAS unsigned char* lds = (LAS unsigned char*)smem;
  const int wbase = __builtin_amdgcn_readfirstlane(wid) * 1024;
  const int half = __builtin_amdgcn_readfirstlane(wid >> 2);
#define G256_ISSUE(kt) do { const int so_ = ((kt) & 1) * LDS_STAGE;                                                      \
    _Pragma("unroll") for (int i = 0; i < 4; ++i) {                                                                      \
      __builtin_amdgcn_global_load_lds((const unsigned*)(ap[i] + (kt) * 64), (LAS unsigned*)(lds + so_ + wbase + i * 8192), 16, 0, 0); \
      __builtin_amdgcn_global_load_lds((const unsigned*)(bp[i] + (kt) * 64), (LAS unsigned*)(lds + so_ + 32768 + wbase + i * 8192), 16, 0, 0); } } while (0)
  __syncthreads();
  G256_ISSUE(0);
  asm volatile("s_waitcnt vmcnt(0)" ::: "memory");
  __syncthreads();
  if (nk > 1) G256_ISSUE(1);
#define G256_BAR() do { __builtin_amdgcn_sched_barrier(0); asm volatile("s_waitcnt lgkmcnt(0)" ::: "memory"); __builtin_amdgcn_s_barrier(); asm volatile("" ::: "memory"); __builtin_amdgcn_sched_barrier(0); } while (0)
#define G256_LOAD(F_A, F_B, SUB) do {                                                                                   \
    const int ch = ((((SUB) * 4) + g4) ^ sw) << 4;                                                                      \
    _Pragma("unroll") for (int mi = 0; mi < 8; ++mi) F_A[mi] = *(const h16x8*)(As + arow0 + mi * 16 * 128 + ch);        \
    _Pragma("unroll") for (int nj = 0; nj < 4; ++nj) F_B[nj] = *(const h16x8*)(Bs + brow0 + nj * 16 * 128 + ch); } while (0)
#define G256_MMA(F_A, F_B) do {                                                                                         \
    _Pragma("unroll") for (int mi = 0; mi < 8; ++mi)                                                                    \
      _Pragma("unroll") for (int nj = 0; nj < 4; ++nj)                                                                  \
        acc[mi][nj] = __builtin_amdgcn_mfma_f32_16x16x32_f16(F_B[nj], F_A[mi], acc[mi][nj], 0, 0, 0); } while (0)
  if (half == 1) G256_BAR();
  for (int t = 0; t < nk; ++t) {
    const unsigned char* As = smem + (t & 1) * LDS_STAGE;
    const unsigned char* Bs = As + 32768;
    {
      if (half == 0 && t >= 1 && t + 1 < nk) G256_ISSUE(t + 1);
      h16x8 fa[8], fb[4];
      G256_LOAD(fa, fb, 0);
      G256_BAR();
      G256_MMA(fa, fb);
      __builtin_amdgcn_sched_barrier(0);
    }
    {
      h16x8 fa[8], fb[4];
      G256_LOAD(fa, fb, 1);
      if (half == 1 && t + 1 < nk) asm volatile("s_waitcnt vmcnt(0)" ::: "memory");
      G256_BAR();
      if (half == 1 && t + 2 < nk) G256_ISSUE(t + 2);
      G256_MMA(fa, fb);
      if (half == 0 && t + 1 < nk) asm volatile("s_waitcnt vmcnt(0)" ::: "memory");
      G256_BAR();
    }
  }
  if (half == 0) G256_BAR();
#undef G256_BAR
#undef G256_LOAD
#undef G256_MMA
#undef G256_ISSUE
  __syncthreads();
}

template <typename ColMap>
__device__ __forceinline__ void transpose_strip(const float* W, int ldw, int k0, h16* dst, int ldt, int n0, ColMap cmap,
                                                unsigned char* smem, const int tid) {
  float* tile = (float*)smem;
  __syncthreads();
  {
    const int nl = tid & 63, kq = tid >> 6;
    float v[4][8];
#pragma unroll
    for (int s = 0; s < 4; ++s) {
      const int sc = cmap(n0 + s * 64 + nl);
#pragma unroll
      for (int t = 0; t < 8; ++t) v[s][t] = W[(size_t)(k0 + kq * 8 + t) * ldw + sc];
    }
#pragma unroll
    for (int s = 0; s < 4; ++s)
#pragma unroll
      for (int t = 0; t < 8; ++t) tile[(kq * 8 + t) * 257 + s * 64 + nl] = v[s][t];
  }
  __syncthreads();
  {
    const int n = tid >> 1, ks = (tid & 1) * 32;
    h16* d = dst + (size_t)(n0 + n) * ldt + k0 + ks;
#pragma unroll
    for (int c = 0; c < 4; ++c) {
      h16x8 o;
#pragma unroll
      for (int t = 0; t < 8; ++t) o[t] = (h16)tile[(ks + c * 8 + t) * 257 + n];
      *(h16x8*)(d + c * 8) = o;
    }
  }
}

__device__ void prep_phase(const Params& p, unsigned char* smem, unsigned* queue) {
  const int nA = 192, nB = 256, nC = 128, nD = 128, nE = 704, nF = 352, nG = 2048, nH = 256, nI = 16, nJ = 4, nS = 49, nK = 1;
  const int total = nA + nB + nC + nD + nE + nF + nG + nH + nI + nJ + nS + nK;
  for (int it0 = blockIdx.x; it0 < total; it0 += gridDim.x) {
    const int tid = opaque_tid();
    int it = total - 1 - it0;
    if (it < nA) {
      const int l = it / 96, col0 = (it % 96) * 64;
      float* sv = (float*)smem;
      float* red = sv + 17 * 256;
      const int j = tid & 63, kg = tid >> 6;
      float acc[17];
#pragma unroll
      for (int i = 0; i < 17; ++i) acc[i] = 0.f;
      for (int kc = 0; kc < 4; ++kc) {
        __syncthreads();
        for (int e = tid; e < 17 * 256; e += NTHREADS) {
          const int i = e >> 8, kk = e & 255;
          const float cv = (i < 16) ? p.c[i * 1024 + kc * 256 + kk] : p.c_ctx[kc * 256 + kk];
          sv[e] = silu_f(cv);
        }
        __syncthreads();
        const float* wp = p.w_ada + ((size_t)l * 1024 + kc * 256 + kg * 32) * 6144 + col0 + j;
#pragma unroll 8
        for (int t = 0; t < 32; ++t) {
          const float w = wp[(size_t)t * 6144];
#pragma unroll
          for (int i = 0; i < 17; ++i) acc[i] += sv[i * 256 + kg * 32 + t] * w;
        }
      }
      __syncthreads();
#pragma unroll
      for (int i = 0; i < 17; ++i) red[(kg * 17 + i) * 64 + j] = acc[i];
      __syncthreads();
      for (int e = tid; e < 17 * 64; e += NTHREADS) {
        const int i = e >> 6, jj = e & 63;
        float s = 0.f;
#pragma unroll
        for (int g = 0; g < 8; ++g) s += red[(g * 17 + i) * 64 + jj];
        p.mod[(size_t)(l * 17 + i) * 6144 + col0 + jj] = s + p.b_ada[l * 6144 + col0 + jj];
      }
      __syncthreads();
      continue;
    }
    it -= nA;
    if (it < nB) {
      const int l = it / 128, r = it % 128, kt = r / 8; int ns = r % 8; if (ns >= 5) ns += 2;
      transpose_strip(p.w_in + (size_t)l * 1024 * 2304, 2304, kt * 64, p.WinT + (size_t)l * ZC * 1024, 1024, ns * 256,
                      [](int n) { return n < 1280 ? n : n - 256; }, smem, tid);
      continue;
    }
    it -= nB;
    if (it < nC) {
      const int l = it / 64, r = it % 64, h = r / 16, k0 = (r % 16) * 64;
      float* tile = (float*)smem;
      float* ct = tile + 64 * 65;
      float* st = ct + 64;
      __syncthreads();
      {
        const int nl = tid & 63, kq = tid >> 6;
        const float* W = p.w_in + (size_t)l * 1024 * 2304;
#pragma unroll
        for (int t = 0; t < 8; ++t) {
          const int k = kq * 8 + t;
          tile[k * 65 + nl] = W[(size_t)(k0 + k) * 2304 + 1280 + h * 64 + nl];
        }
        if (tid < 64) { ct[tid] = cospif((float)tid / 32.f) * 0.125f; st[tid] = sinpif((float)tid / 32.f) * 0.125f; }
      }
      __syncthreads();
      {
        const int k2 = tid & 63, kq = tid >> 6;
        h16* dc = p.WinT + ((size_t)l * ZC + 1280 + h * 64 + k2) * 1024 + k0;
        h16* ds = p.WinT + ((size_t)l * ZC + 1536 + h * 64 + k2) * 1024 + k0;
        for (int t = 0; t < 8; ++t) {
          const int k = kq * 8 + t;
          float ac = 0.f, as = 0.f;
#pragma unroll 8
          for (int d = 0; d < 64; ++d) {
            const float w = tile[k * 65 + d];
            const int idx = (k2 * d) & 63;
            ac += w * ct[idx]; as += w * st[idx];
          }
          dc[k] = (h16)ac; ds[k] = (h16)as;
        }
      }
      __syncthreads();
      continue;
    }
    it -= nC;
    if (it < nD) {
      const int l = it / 64, r = it % 64, kt = r / 4, ns = r % 4;
      transpose_strip(p.w_out + (size_t)l * 1024 * 1024, 1024, kt * 64, p.WoutT + (size_t)l * 1024 * 1024, 1024, ns * 256,
                      [](int n) { return n; }, smem, tid);
      continue;
    }
    it -= nD;
    if (it < nE) {
      const int l = it / 352, r = it % 352, kt = r / 22, ns = r % 22;
      transpose_strip(p.w_up + (size_t)l * 1024 * 5632, 5632, kt * 64, p.WupT + (size_t)l * 5632 * 1024, 1024, ns * 256,
                      [](int n) { const int t = n >> 8, cc = n & 255; const int j = t * 128 + (cc >> 6) * 32 + ((cc >> 5) & 1) * 16 + (cc & 15);
                                  return ((cc >> 4) & 1) ? DFF + j : j; }, smem, tid);
      continue;
    }
    it -= nE;
    if (it < nF) {
      const int l = it / 176, r = it % 176, kt = r / 4, ns = r % 4;
      transpose_strip(p.w_down + (size_t)l * DFF * 1024, 1024, kt * 64, p.WdownT + (size_t)l * 1024 * DFF, DFF, ns * 256,
                      [](int n) { return n; }, smem, tid);
      continue;
    }
    it -= nF;
    if (it < nG) {
      const int k1 = it;
      const float sc = 0.02209708691207961f;
      h16x8 v0;
#pragma unroll
      for (int e = 0; e < 8; ++e) {
        const int kk = tid * 8 + e;
        const int n = kk & 2047;
        const int m = (k1 * n) & 2047;
        const float a = (float)m / 1024.f;
        v0[e] = (h16)((kk < 2048) ? cospif(a) * sc : -sinpif(a) * sc);
      }
      *(h16x8*)(p.Fn + (size_t)k1 * 4096 + tid * 8) = v0;
      continue;
    }
    it -= nG;
    if (it < nH) {
      const int k1 = it;
      const int kk = tid;
      const int n = kk & 255;
      const int m = (k1 * n) & 255;
      const float a = (float)m / 128.f;
      p.Fc[(size_t)k1 * 512 + kk] = (h16)((kk < 256) ? cospif(a) * 0.0625f : -sinpif(a) * 0.0625f);
      continue;
    }
    it -= nH;
    if (it < nI) {
      const int base = it * 8192 + tid * 16;
#pragma unroll
      for (int e = 0; e < 16; ++e) p.Ws16[base + e] = (h16)p.gm_ws[base + e];
      continue;
    }
    it -= nI;
    if (it < nJ) {
      const int n = it * 512 + tid;
      const float row = (float)(n >> 6), col = (float)(n & 63);
      float* d = p.rope + (size_t)n * 32;
#pragma unroll
      for (int i = 0; i < 8; ++i) {
        const float invf = powf(10000.f, -(float)(2 * i) / 16.f);
        const float ar = row * invf, ac = col * invf;
        d[i] = cosf(ar); d[8 + i] = sinf(ar); d[16 + i] = cosf(ac); d[24 + i] = sinf(ac);
      }
      continue;
    }
    it -= nJ;
    if (it < nS) {
      const int idx = it * 512 + tid;
      if (idx < SM_TOTAL) {
        float v;
        if (idx < SM_G2) v = p.g1_in[idx - SM_G1];
        else if (idx < SM_GMBS) v = p.g2_in[idx - SM_G2];
        else if (idx < SM_SCW) v = p.gm_bs_in[idx - SM_GMBS];
        else if (idx < SM_SUBLN) v = p.sc_w_in[idx - SM_SCW];
        else if (idx < SM_FFNCONV) v = p.subln_in[idx - SM_SUBLN];
        else if (idx < SM_FINALG) v = p.ffn_conv_in[idx - SM_FFNCONV];
        else v = p.final_g_in[idx - SM_FINALG];
        ((float*)p.g1)[idx] = v;
      }
      continue;
    }
    it -= nS;
    {
      for (int e = tid; e < 2048; e += NTHREADS) ((unsigned*)p.zero)[e] = 0u;
      if (tid < 2) {
        const int l = tid;
        float s1 = 0.f, s2 = 0.f;
        for (int i = 0; i < 32; ++i) { s1 += p.lq1[l * 32 + i] * p.lk1[l * 32 + i]; s2 += p.lq2[l * 32 + i] * p.lk2[l * 32 + i]; }
        const float lam_init = 0.8f - 0.6f * expf(-0.3f * (float)l);
        p.lam[l] = expf(s1) - expf(s2) + lam_init;
        p.lam[2 + l] = lam_init;
      }
    }
  }
}

__device__ __forceinline__ float wave_sum(float v) {
#pragma unroll
  for (int o = 32; o >= 1; o >>= 1) v += __shfl_xor(v, o);
  return v;
}

__device__ void norm_phase(const Params& p, int l, int which  , bool from_input, int nrows) {
  const int tid_ = opaque_tid(); const int lane = tid_ & 63, wid = tid_ >> 6;
  const float* gv = (which == 0 ? p.g1 : p.g2) + l * 1024;
  const int sh_off = which == 0 ? 0 : 3072, sc_off = which == 0 ? 1024 : 4096;
  for (int row = blockIdx.x * NWAVES + wid; row < nrows; row += gridDim.x * NWAVES) {
    const float* xr;
    if (row < NLAT) xr = (from_input ? p.x : p.out) + (size_t)row * 1024;
    else xr = (from_input ? p.ctx : p.Xc) + (size_t)(row - NLAT) * 1024;
    f32x4 v[4];
    float ss = 0.f;
#pragma unroll
    for (int i = 0; i < 4; ++i) {
      v[i] = *(const f32x4*)(xr + i * 256 + lane * 4);
      ss += v[i][0] * v[i][0] + v[i][1] * v[i][1] + v[i][2] * v[i][2] + v[i][3] * v[i][3];
    }
    ss = wave_sum(ss);
    const float rstd = rsqrtf(ss * (1.f / 1024.f) + EPS);
    const int mi = row < NLAT ? (row >> 11) : 16;
    const float* md = p.mod + (size_t)(l * 17 + mi) * 6144;
#pragma unroll
    for (int i = 0; i < 4; ++i) {
      const int k = i * 256 + lane * 4;
      const f32x4 g = *(const f32x4*)(gv + k), sc = *(const f32x4*)(md + sc_off + k), sh = *(const f32x4*)(md + sh_off + k);
      float y[4];
#pragma unroll
      for (int e = 0; e < 4; ++e) y[e] = v[i][e] * rstd * g[e] * (1.f + sc[e]) + sh[e];
      *(h16x4*)(p.H16 + (size_t)row * 1024 + k) = pack4(y[0], y[1], y[2], y[3]);
    }
  }
}

__device__ void final_norm_phase(const Params& p) {
  const int tid_ = opaque_tid(); const int lane = tid_ & 63, wid = tid_ >> 6;
  for (int row = blockIdx.x * NWAVES + wid; row < NLAT; row += gridDim.x * NWAVES) {
    float* xr = p.out + (size_t)row * 1024;
    f32x4 v[4];
    float ss = 0.f;
#pragma unroll
    for (int i = 0; i < 4; ++i) {
      v[i] = *(const f32x4*)(xr + i * 256 + lane * 4);
      ss += v[i][0] * v[i][0] + v[i][1] * v[i][1] + v[i][2] * v[i][2] + v[i][3] * v[i][3];
    }
    ss = wave_sum(ss);
    const float rstd = rsqrtf(ss * (1.f / 1024.f) + EPS);
#pragma unroll
    for (int i = 0; i < 4; ++i) {
      const int k = i * 256 + lane * 4;
      const f32x4 g = *(const f32x4*)(p.final_g + k);
      f32x4 y;
#pragma unroll
      for (int e = 0; e < 4; ++e) y[e] = v[i][e] * rstd * g[e];
      *(f32x4*)(xr + k) = y;
    }
  }
}

__device__ __forceinline__ void rope16(f32x4& a, const float* tab, const int g4, const bool on) {
  f32x4 pr;
#pragma unroll
  for (int e = 0; e < 4; ++e) pr[e] = __shfl_xor(a[e], 32);
  if (on) {
    const f32x4 c = *(const f32x4*)(tab), s = *(const f32x4*)(tab + 8);
#pragma unroll
    for (int e = 0; e < 4; ++e) a[e] = (g4 < 2) ? (a[e] * c[e] - pr[e] * s[e]) : (a[e] * c[e] + pr[e] * s[e]);
  }
}

__device__ __forceinline__ int vblock() { return (blockIdx.x & 7) * (gridDim.x >> 3) + (blockIdx.x >> 3); }
__device__ __forceinline__ void tile_map(int it, int nMt, int nNt, int PM, int& mt, int& nt) {
  const int per = PM * nNt;
  const int panel = it / per, rem = it - panel * per, m0 = panel * PM;
  const int pmw = (nMt - m0) < PM ? (nMt - m0) : PM;
  nt = rem / pmw; mt = m0 + rem % pmw;
}
#define TID_DECL const int tid = opaque_tid(), lane = tid & 63, wid = tid >> 6, wm = wid >> 2, wn = wid & 3, l15 = lane & 15, g4 = lane >> 4;

__device__ void p1_phase(const Params& p, int l, unsigned char* smem) {
  const h16* WT = p.WinT + (size_t)l * ZC * 1024;
  const int nmain = (l == 0) ? 144 * 10 : 128 * 10, nextra = (l == 0) ? 0 : 32;
  for (int t = vblock(); t < nmain + nextra; t += gridDim.x) {
    TID_DECL
    int tm, tn;
    if (t < nmain) tile_map(t, (l == 0) ? 144 : 128, 10, 16, tm, tn);
    else { const int u = t - nmain; tm = 128 + (u & 15); tn = 8 + (u >> 4); }
    f32x4 acc[8][4];
    const h16* Abase = p.H16 + (size_t)tm * 256 * 1024;
    gemm256(acc, [&](int i) { return Abase + (size_t)i * 1024; }, WT + (size_t)tn * 256 * 1024, 1024, 1024, smem, tid);
    const int g = tn;
    const int cgw = wn * 64 + 4 * g4;
#pragma unroll
    for (int mi = 0; mi < 8; ++mi) {
      const int R = tm * 256 + wm * 128 + mi * 16 + l15;
      const bool isctx = R >= NLAT;
      int b, pos;
      if (!isctx) { b = R >> 11; pos = R & 2047; } else { const int rc = R - NLAT; b = rc >> 8; pos = rc & 255; }
      if (g == 0) {
#pragma unroll
        for (int nj = 0; nj < 4; ++nj) {
          const f32x4& a = acc[mi][nj];
          *(h16x4*)(p.U16 + (size_t)R * 256 + cgw + nj * 16) = pack4(gelu_f(a[0]), gelu_f(a[1]), gelu_f(a[2]), gelu_f(a[3]));
        }
      } else if (g == 1) {
        float ss = 0.f;
#pragma unroll
        for (int nj = 0; nj < 4; ++nj)
#pragma unroll
          for (int e = 0; e < 4; ++e) { const float v = gelu_f(acc[mi][nj][e]); acc[mi][nj][e] = v; ss += v * v; }
        ss += __shfl_xor(ss, 16);
        ss += __shfl_xor(ss, 32);
        const float rinv = rsqrtf(ss * (1.f / 64.f) + EPS);
        const int head = wn;
        h16* base; int stride;
        if (!isctx) { base = p.VTl + ((size_t)(head * 1024 + b * 64) * 2048 + pos); stride = 2048; }
        else { base = p.VTc + ((size_t)(head * 1024 + b * 64) * 256 + pos); stride = 256; }
#pragma unroll
        for (int nj = 0; nj < 4; ++nj)
#pragma unroll
          for (int e = 0; e < 4; ++e) {
            const int d = nj * 16 + 4 * g4 + e;
            base[(size_t)d * stride] = (h16)(acc[mi][nj][e] * rinv);
          }
      } else if (g <= 4) {
#pragma unroll
        for (int nj = 0; nj < 4; ++nj) {
          const f32x4& a = acc[mi][nj];
          *(h16x4*)(p.ZB + (size_t)R * 768 + (g - 2) * 256 + cgw + nj * 16) = pack4(a[0], a[1], a[2], a[3]);
        }
      } else if (g <= 6) {
        h16* base; int stride;
        if (!isctx) { base = p.GTl + ((size_t)(b * 256 + cgw) * 4096 + (g == 6 ? 2048 : 0) + pos); stride = 4096; }
        else { base = p.GTc + ((size_t)(b * 256 + cgw) * 512 + (g == 6 ? 256 : 0) + pos); stride = 512; }
#pragma unroll
        for (int nj = 0; nj < 4; ++nj)
#pragma unroll
          for (int e = 0; e < 4; ++e) base[(size_t)(nj * 16 + e) * stride] = (h16)acc[mi][nj][e];
      } else if (g == 7) {
        const float qs = 0.17677669529663687f * 1.4426950408889634f;
#pragma unroll
        for (int nj = 0; nj < 4; ++nj) {
          rope16(acc[mi][nj], p.rope + (size_t)pos * 32 + (nj & 1) * 16 + 4 * (g4 & 1), g4, !isctx);
          const f32x4& a = acc[mi][nj];
          *(h16x4*)(p.Q16 + (size_t)R * 256 + cgw + nj * 16) = pack4(a[0] * qs, a[1] * qs, a[2] * qs, a[3] * qs);
        }
      } else if (g == 8) {
        const int key = isctx ? pos : 256 + pos;
#pragma unroll
        for (int nj = 0; nj < 4; ++nj) {
          rope16(acc[mi][nj], p.rope + (size_t)pos * 32 + (nj & 1) * 16 + 4 * (g4 & 1), g4, !isctx);
          const f32x4& a = acc[mi][nj];
          *(h16x4*)(p.K16 + ((size_t)b * NKEY + key) * 256 + cgw + nj * 16) = pack4(a[0], a[1], a[2], a[3]);
        }
      } else {
        const int key = isctx ? pos : 256 + pos;
        h16* base = p.VT16 + ((size_t)(b * 256 + cgw) * NKEY + key);
#pragma unroll
        for (int nj = 0; nj < 4; ++nj)
#pragma unroll
          for (int e = 0; e < 4; ++e) base[(size_t)(nj * 16 + e) * NKEY] = (h16)acc[mi][nj][e];
      }
    }
  }
}

__device__ void attn_unit(const Params& p, int l, int b, int h, int qrow0, int nkeys, unsigned char* smem, const int tid) {
  const int lane = tid & 63, w = tid >> 6, l31 = lane & 31, hf = lane >> 5;
  const h16* Kbase = p.K16 + (size_t)b * NKEY * 256 + h * 64;
  const h16* Vbase = p.VT16 + (size_t)(b * 256 + h * 64) * NKEY;
  const int qrow = qrow0 + w * 32 + l31;
  h16x8 qf0[2][2];
#pragma unroll
  for (int m = 0; m < 2; ++m)
#pragma unroll
    for (int s = 0; s < 2; ++s) qf0[m][s] = *(const h16x8*)(p.Q16 + (size_t)qrow * 256 + h * 64 + m * 32 + s * 16 + hf * 8);
  unsigned char* Qs = smem + 49152 + tid * 16;
  f32x16 O[2][2];
#pragma unroll
  for (int m = 0; m < 2; ++m)
#pragma unroll
    for (int dt = 0; dt < 2; ++dt)
#pragma unroll
      for (int r = 0; r < 16; ++r) O[m][dt][r] = 0.f;
  float mrun[2] = {0.f, 0.f}, lsum[2] = {0.f, 0.f};
  const int sr = tid >> 3, sc = tid & 7;
  const int gc = (sc ^ ((sr >> 1) & 7)) * 8;
  const h16* kp = Kbase + (size_t)sr * 256 + gc;
  const h16* vp = Vbase + (size_t)sr * NKEY + gc;
  LAS unsigned char* lds = (LAS unsigned char*)smem;
  const int wbase = __builtin_amdgcn_readfirstlane(w) * 1024;
  const int nt = nkeys >> 6;
#define ATT_ISSUE(kt, st) do {                                                                                           \
    __builtin_amdgcn_global_load_lds((const unsigned*)(kp + (size_t)(kt) * 64 * 256), (LAS unsigned*)(lds + (st) * 16384 + wbase), 16, 0, 0); \
    __builtin_amdgcn_global_load_lds((const unsigned*)(vp + (kt) * 64), (LAS unsigned*)(lds + (st) * 16384 + 8192 + wbase), 16, 0, 0); } while (0)
  const int ksw = (l31 >> 1) & 7;
#define ATT_QK(S, Ks_, m_, sub_) do {                                                                                    \
    const float nm_ = -mrun[m_];                                                                                         \
    _Pragma("unroll") for (int r = 0; r < 16; ++r) S[r] = nm_;                                                           \
    _Pragma("unroll") for (int s = 0; s < 2; ++s) {                                                                      \
      const int ch = (((m_) * 4 + s * 2 + hf) ^ ksw) << 4;                                                               \
      const h16x8 kf = *(const h16x8*)((Ks_) + ((sub_) * 32 + l31) * 128 + ch);                                          \
      const h16x8 qv = *(const h16x8*)(Qs + ((m_) * 2 + s) * 8192);                                                      \
      S = __builtin_amdgcn_mfma_f32_32x32x16_f16(kf, qv, S, 0, 0, 0); } } while (0)
  __syncthreads();
#pragma unroll
  for (int m = 0; m < 2; ++m)
#pragma unroll
    for (int s = 0; s < 2; ++s) *(h16x8*)(Qs + (m * 2 + s) * 8192) = qf0[m][s];
  ATT_ISSUE(0, 0);
  if (nt > 1) ATT_ISSUE(1, 1);
  asm volatile("s_waitcnt vmcnt(0)" ::: "memory");
  __syncthreads();
  f32x16 scur[2];
  ATT_QK(scur[0], smem, 0, 0);
  ATT_QK(scur[1], smem, 1, 0);
  int st = 0;
  for (int kt = 0; kt < nt; ++kt) {
    const int st1 = (st == 2) ? 0 : st + 1, st2 = (st1 == 2) ? 0 : st1 + 1;
    if (kt + 2 < nt) ATT_ISSUE(kt + 2, st2);
    const unsigned char* Kc = smem + st * 16384;
    const unsigned char* Vs = Kc + 8192;
    const unsigned char* Kn = smem + st1 * 16384;
#pragma unroll
    for (int sub = 0; sub < 2; ++sub) {
      const bool more = (sub == 0) || (kt + 1 < nt);
      const bool first = (kt == 0) && (sub == 0);
#pragma unroll
      for (int m = 0; m < 2; ++m) {
        f32x16 sn;
        if (more) { if (sub == 0) ATT_QK(sn, Kc, m, 1); else ATT_QK(sn, Kn, m, 0); }
        f32x16& s0 = scur[m];
        h16x8 pf[2];
        {
          float mx = s0[0];
#pragma unroll
          for (int r = 1; r < 16; ++r) mx = fmaxf(mx, s0[r]);
          mx = fmaxf(mx, __shfl_xor(mx, 32));
          if (__any(first || (mx > 8.f))) {
            const float delta = first ? mx : fmaxf(mx, 0.f);
            const float alpha = first ? 1.f : __builtin_amdgcn_exp2f(-delta);
            mrun[m] += delta;
            lsum[m] *= alpha;
#pragma unroll
            for (int r = 0; r < 16; ++r) s0[r] -= delta;
            if (more) {
#pragma unroll
              for (int r = 0; r < 16; ++r) sn[r] -= delta;
            }
#pragma unroll
            for (int dt = 0; dt < 2; ++dt)
#pragma unroll
              for (int r = 0; r < 16; ++r) O[m][dt][r] *= alpha;
          }
          float ps = 0.f;
#pragma unroll
          for (int r = 0; r < 16; ++r) { s0[r] = __builtin_amdgcn_exp2f(s0[r]); ps += s0[r]; }
          lsum[m] += ps;
#pragma unroll
          for (int sp = 0; sp < 2; ++sp) {
            u32x4 w0;
#pragma unroll
            for (int j = 0; j < 4; ++j)
              w0[j] = __builtin_bit_cast(unsigned, __builtin_amdgcn_cvt_pkrtz(s0[8 * sp + 2 * j], s0[8 * sp + 2 * j + 1]));
            pf[sp] = __builtin_bit_cast(h16x8, w0);
          }
        }
#pragma unroll
        for (int dt = 0; dt < 2; ++dt)
#pragma unroll
          for (int sp = 0; sp < 2; ++sp) {
            const int gA = sub * 8 + 4 * sp + hf, gB = gA + 2;
            const int vrow = (dt * 32 + l31) * 128;
            const h16x4 lo = *(const h16x4*)(Vs + vrow + ((((gA >> 1) ^ ksw) << 4) | ((gA & 1) << 3)));
            const h16x4 hi = *(const h16x4*)(Vs + vrow + ((((gB >> 1) ^ ksw) << 4) | ((gB & 1) << 3)));
            h16x8 vf;
            vf[0] = lo[0]; vf[1] = lo[1]; vf[2] = lo[2]; vf[3] = lo[3]; vf[4] = hi[0]; vf[5] = hi[1]; vf[6] = hi[2]; vf[7] = hi[3];
            O[m][dt] = __builtin_amdgcn_mfma_f32_32x32x16_f16(vf, pf[sp], O[m][dt], 0, 0, 0);
          }
        if (more) s0 = sn;
      }
    }
    asm volatile("s_waitcnt vmcnt(0)" ::: "memory");
    __syncthreads();
    st = st1;
  }
#undef ATT_ISSUE
#undef ATT_QK
  const float lam = ldvol(p.lam + l), lam_init = ldvol(p.lam + 2 + l);
  float l0 = lsum[0] + __shfl_xor(lsum[0], 32), l1 = lsum[1] + __shfl_xor(lsum[1], 32);
  const float i0 = 1.f / l0, i1 = lam / l1;
  float ss = 0.f;
#pragma unroll
  for (int dt = 0; dt < 2; ++dt)
#pragma unroll
    for (int r = 0; r < 16; ++r) { const float o = O[0][dt][r] * i0 - O[1][dt][r] * i1; O[0][dt][r] = o; ss += o * o; }
  ss += __shfl_xor(ss, 32);
  const float rinv = rsqrtf(ss * (1.f / 64.f) + EPS) * (1.f - lam_init);
  h16* orow = p.H16 + (size_t)qrow * 1024 + 768 + h * 64;
#pragma unroll
  for (int dt = 0; dt < 2; ++dt)
#pragma unroll
    for (int q = 0; q < 4; ++q) {
      const int d = dt * 32 + q * 8 + hf * 4;
      const f32x4 g = *(const f32x4*)(p.subln + l * 64 + d);
      *(h16x4*)(orow + d) = pack4(O[0][dt][4 * q] * rinv * g[0], O[0][dt][4 * q + 1] * rinv * g[1],
                                  O[0][dt][4 * q + 2] * rinv * g[2], O[0][dt][4 * q + 3] * rinv * g[3]);
    }
}

__device__ void p2_phase(const Params& p, int l, unsigned char* smem, unsigned* queue) {
  const bool ctxon = (l == 0);
  const int nDl = 80, nAl = 512, nAc = ctxon ? 64 : 0, nDc = ctxon ? 16 : 0, nGl = 256, nGc = ctxon ? 32 : 0;
  const int nBrows = ctxon ? NTOK : NLAT, nB = nBrows / 16;
  const int total = nDl + nAl + nAc + nDc + nGl + nGc + nB;
  h16* MIX = p.H16;
  int* qslot = (int*)(smem + LDS_BYTES - 16);
  for (;;) {
    TID_DECL
    __syncthreads();
    if (tid == 0) *qslot = (int)__hip_atomic_fetch_add(queue, 1u, __ATOMIC_RELAXED, __HIP_MEMORY_SCOPE_AGENT);
    __syncthreads();
    int it = *qslot;
    if (it >= total) break;
    if (it < nDl) {
      const int tm = it >> 4, tn = it & 15;
      f32x4 acc[8][4];
      const h16* Ab = p.Fn + (size_t)tm * 256 * 4096;
      gemm256(acc, [&](int i) { return Ab + (size_t)i * 4096; }, p.GTl + (size_t)tn * 256 * 4096, 4096, 4096, smem, tid);
      const int b = tn, c0 = wn * 64 + 4 * g4;
#pragma unroll
      for (int mi = 0; mi < 8; ++mi) {
        const int k1 = tm * 256 + wm * 128 + mi * 16 + l15;
        h16* o = MIX + ((size_t)b * 2048 + k1) * 1024 + 512 + c0;
#pragma unroll
        for (int nj = 0; nj < 4; ++nj) {
          const f32x4& a = acc[mi][nj];
          *(h16x4*)(o + nj * 16) = pack4(a[0], a[1], a[2], a[3]);
        }
        if (k1 >= 1 && k1 <= 768) {
          h16* om = MIX + ((size_t)b * 2048 + (2048 - k1)) * 1024 + 512 + wn * 64;
#pragma unroll
          for (int nj = 0; nj < 4; ++nj)
#pragma unroll
            for (int e = 0; e < 4; ++e) om[(64 - (nj * 16 + 4 * g4 + e)) & 63] = (h16)acc[mi][nj][e];
        }
      }
      continue;
    }
    it -= nDl;
    if (it < nAl) {
      const int qb = it & 7, h = (it >> 3) & 3, b = it >> 5;
      attn_unit(p, l, b, h, b * 2048 + qb * 256, NKEY, smem, tid);
      continue;
    }
    it -= nAl;
    if (it < nAc) {
      const int h = it & 3, b = it >> 2;
      attn_unit(p, l, b, h, NLAT + b * 256, 256, smem, tid);
      continue;
    }
    it -= nAc;
    if (it < nDc) {
      const int tn = it;
      f32x4 acc[8][4];
      gemm256(acc, [&](int i) { return p.Fc + (size_t)i * 512; }, p.GTc + (size_t)tn * 256 * 512, 512, 512, smem, tid);
      const int b = tn, c0 = wn * 64 + 4 * g4;
#pragma unroll
      for (int mi = 0; mi < 8; ++mi) {
        const int k1 = wm * 128 + mi * 16 + l15;
        h16* o = MIX + ((size_t)NLAT + b * 256 + k1) * 1024 + 512 + c0;
#pragma unroll
        for (int nj = 0; nj < 4; ++nj) {
          const f32x4& a = acc[mi][nj];
          *(h16x4*)(o + nj * 16) = pack4(a[0], a[1], a[2], a[3]);
        }
      }
      continue;
    }
    it -= nDc;
    if (it < nGl + nGc) {
      const bool isc = it >= nGl;
      int h, c, tn;
      if (!isc) { tn = it & 3; c = (it >> 2) & 15; h = it >> 6; }
      else { const int u = it - nGl; tn = u & 3; c = (u >> 2) & 1; h = u >> 3; }
      const int ldb = isc ? 256 : 2048;
      const h16* Bt = (isc ? p.VTc : p.VTl) + (size_t)(h * 1024 + tn * 256) * ldb + c * 128;
      const h16* Ab = p.Ws16 + (size_t)(l * 4 + h) * 128 * 128;
      f32x4 acc[8][4];
      gemm256(acc, [&](int i) { return i < 128 ? Ab + (size_t)i * 128 : p.zero; }, Bt, ldb, 128, smem, tid);
      if (wm == 0) {
#pragma unroll
        for (int mi = 0; mi < 8; ++mi) {
          const int pp = mi * 16 + l15;
          const float bias = p.gm_bs[(l * 4 + h) * 128 + pp];
#pragma unroll
          for (int nj = 0; nj < 4; ++nj) {
            const int ng = tn * 256 + wn * 64 + nj * 16;
            const int b = ng >> 6, d = (ng & 63) + 4 * g4;
            const size_t R = isc ? ((size_t)NLAT + b * 256 + c * 128 + pp) : ((size_t)b * 2048 + c * 128 + pp);
            const h16x4 u = *(const h16x4*)(p.U16 + R * 256 + h * 64 + d);
            const f32x4& a = acc[mi][nj];
            *(h16x4*)(MIX + R * 1024 + h * 64 + d) =
                pack4((a[0] + bias) * (float)u[0], (a[1] + bias) * (float)u[1], (a[2] + bias) * (float)u[2], (a[3] + bias) * (float)u[3]);
          }
        }
      }
      continue;
    }
    it -= nGl + nGc;
    {
      const int R = it * 16 + (tid >> 5);
      const int j0 = (tid & 31) * 8;
      int pos, len;
      if (R < NLAT) { pos = R & 2047; len = 2048; } else { pos = (R - NLAT) & 255; len = 256; }
      const h16* zr = p.ZB + (size_t)R * 768;
      float P[3][8];
#pragma unroll
      for (int dlt = 0; dlt < 3; ++dlt) {
        const int pp = pos + dlt - 1;
        if (pp >= 0 && pp < len) {
          const h16x8 bx = *(const h16x8*)(zr + (dlt - 1) * 768 + j0);
          const h16x8 bc = *(const h16x8*)(zr + (dlt - 1) * 768 + 512 + j0);
#pragma unroll
          for (int e = 0; e < 8; ++e) P[dlt][e] = (float)bx[e] * (float)bc[e];
        } else {
#pragma unroll
          for (int e = 0; e < 8; ++e) P[dlt][e] = 0.f;
        }
      }
      const h16x8 bb = *(const h16x8*)(zr + 256 + j0);
      const float* w = p.sc_w + l * 768 + j0;
      h16x8 o;
#pragma unroll
      for (int e = 0; e < 8; ++e)
        o[e] = (h16)((float)bb[e] * (w[e] * P[0][e] + w[256 + e] * P[1][e] + w[512 + e] * P[2][e]));
      *(h16x8*)(MIX + (size_t)R * 1024 + 256 + j0) = o;
    }
  }
}

__device__ void resid_gemm_phase(const Params& p, int l, int which  , bool from_input, int nrows,
                                 unsigned char* smem) {
  const int ntiles = (nrows / 256) * 4;
  const h16* A = which == 0 ? p.H16 : p.ACT;
  const int K = which == 0 ? 1024 : DFF;
  const h16* WT = which == 0 ? p.WoutT + (size_t)l * 1024 * 1024 : p.WdownT + (size_t)l * 1024 * DFF;
  const int goff = which == 0 ? 2048 : 5120;
  for (int t = vblock(); t < ntiles; t += gridDim.x) {
    TID_DECL
    int tm, tn;
    tile_map(t, nrows / 256, 4, 8, tm, tn);
    f32x4 acc[8][4];
    const h16* Ab = A + (size_t)tm * 256 * K;
    gemm256(acc, [&](int i) { return Ab + (size_t)i * K; }, WT + (size_t)tn * 256 * K, K, K, smem, tid);
#pragma unroll
    for (int mi = 0; mi < 8; ++mi) {
      const int R = tm * 256 + wm * 128 + mi * 16 + l15;
      const float* xin; float* xo; int mod_i;
      if (R < NLAT) { xin = (from_input ? p.x : p.out) + (size_t)R * 1024; xo = p.out + (size_t)R * 1024; mod_i = R >> 11; }
      else { xin = (from_input ? p.ctx : p.Xc) + (size_t)(R - NLAT) * 1024; xo = p.Xc + (size_t)(R - NLAT) * 1024; mod_i = 16; }
      const float* gt = p.mod + (size_t)(l * 17 + mod_i) * 6144 + goff;
#pragma unroll
      for (int nj = 0; nj < 4; ++nj) {
        const int n = tn * 256 + wn * 64 + nj * 16 + 4 * g4;
        const f32x4 xi = *(const f32x4*)(xin + n), gg = *(const f32x4*)(gt + n);
        const f32x4& a = acc[mi][nj];
        f32x4 y;
#pragma unroll
        for (int e = 0; e < 4; ++e) y[e] = xi[e] + gg[e] * a[e];
        *(f32x4*)(xo + n) = y;
      }
    }
  }
}

__device__ void p4_phase(const Params& p, int l, int nrows, unsigned char* smem) {
  const int nmt = (nrows + 253) / 254;
  const int ntiles = nmt * 22;
  const h16* WT = p.WupT + (size_t)l * 5632 * 1024;
  const float* cw = p.ffn_conv + (size_t)l * 3 * DFF;
  h16* abuf = (h16*)smem;
  for (int it = vblock(); it < ntiles; it += gridDim.x) {
    TID_DECL
    int nt, t;
    tile_map(it, nmt, 22, 16, t, nt);
    const int R0 = 254 * t - 1;
    f32x4 acc[8][4];
    gemm256(acc, [&](int i) -> const h16* { const int R = R0 + i; return (R >= 0 && R < nrows) ? p.H16 + (size_t)R * 1024 : p.zero; },
            WT + (size_t)nt * 256 * 1024, 1024, 1024, smem, tid);
#pragma unroll
    for (int mi = 0; mi < 8; ++mi) {
      const int m = wm * 128 + mi * 16 + l15;
#pragma unroll
      for (int pj = 0; pj < 2; ++pj)
        *(h16x4*)(abuf + m * 136 + wn * 32 + pj * 16 + 4 * g4) =
            pack4(acc[mi][2 * pj][0], acc[mi][2 * pj][1], acc[mi][2 * pj][2], acc[mi][2 * pj][3]);
    }
    __syncthreads();
#pragma unroll
    for (int mi = 0; mi < 8; ++mi) {
      const int m = wm * 128 + mi * 16 + l15;
      const int R = R0 + m;
      if (m >= 1 && m <= 254 && R < nrows) {
        int ps, len;
        if (R < NLAT) { ps = R & 2047; len = 2048; } else { ps = (R - NLAT) & 255; len = 256; }
        const float mp = (ps == 0) ? 0.f : 1.f, mn = (ps == len - 1) ? 0.f : 1.f;
#pragma unroll
        for (int pj = 0; pj < 2; ++pj) {
          const int ja = wn * 32 + pj * 16 + 4 * g4;
          const int j = nt * 128 + ja;
          const h16x4 ap = *(const h16x4*)(abuf + (m - 1) * 136 + ja), an = *(const h16x4*)(abuf + (m + 1) * 136 + ja);
          const f32x4 w0 = *(const f32x4*)(cw + j), w1 = *(const f32x4*)(cw + DFF + j), w2 = *(const f32x4*)(cw + 2 * DFF + j);
          float y[4];
#pragma unroll
          for (int e = 0; e < 4; ++e) {
            const float cv = w0[e] * mp * (float)ap[e] + w1[e] * acc[mi][2 * pj][e] + w2[e] * mn * (float)an[e];
            y[e] = silu_f(cv) * acc[mi][2 * pj + 1][e];
          }
          *(h16x4*)(p.ACT + (size_t)R * DFF + j) = pack4(y[0], y[1], y[2], y[3]);
        }
      }
    }
  }
}

__device__ __forceinline__ void grid_bar(unsigned* ctr, unsigned target) {
  asm volatile("s_waitcnt vmcnt(0) lgkmcnt(0)" ::: "memory");
  __syncthreads();
  if (threadIdx.x == 0) {
    __builtin_amdgcn_fence(__ATOMIC_RELEASE, "agent");
    asm volatile("s_waitcnt vmcnt(0)" ::: "memory");
    __hip_atomic_fetch_add(ctr, 1u, __ATOMIC_RELAXED, __HIP_MEMORY_SCOPE_AGENT);
    while (__hip_atomic_load(ctr, __ATOMIC_RELAXED, __HIP_MEMORY_SCOPE_AGENT) < target) __builtin_amdgcn_s_sleep(2);
    __builtin_amdgcn_fence(__ATOMIC_ACQUIRE, "agent");
    asm volatile("s_waitcnt vmcnt(0)" ::: "memory");
  }
  __syncthreads();
}

__global__ void __launch_bounds__(NTHREADS, 2) mega_kernel(KArgs ka) {
  __shared__ __attribute__((aligned(1024))) unsigned char smem[LDS_BYTES];
  cg::grid_group grid = cg::this_grid();
  const Params p = make_params(ka);
  if (blockIdx.x == 0 && threadIdx.x < 8) __hip_atomic_store(p.bar + threadIdx.x * 16, 0u, __ATOMIC_RELAXED, __HIP_MEMORY_SCOPE_AGENT);
  unsigned nbar = 0;
  const unsigned G = gridDim.x;
#define GBAR() do { ++nbar; grid_bar(p.bar, nbar * G); } while (0)
  prep_phase(p, smem, p.bar + 16 * 5);
  grid.sync();
  norm_phase(p, 0, 0, true, NTOK);
  GBAR();
  for (int l = 0; l < 2; ++l) {
    const bool first = (l == 0);
    const int nrows = first ? NTOK : NLAT;
    p1_phase(p, l, smem);
    GBAR();
    p2_phase(p, l, smem, p.bar + 16 * (1 + l));
    GBAR();
    resid_gemm_phase(p, l, 0, first, nrows, smem);
    GBAR();
    norm_phase(p, l, 1, false, nrows);
    GBAR();
    p4_phase(p, l, nrows, smem);
    GBAR();
    resid_gemm_phase(p, l, 1, false, nrows, smem);
    GBAR();
    if (first) { norm_phase(p, 1, 0, false, NTOK); GBAR(); }
  }
  final_norm_phase(p);
}

extern "C" void kernel_launch(void* const* d_in, const int* in_sizes, int n_in, void* d_out, int out_size, void* d_ws,
                              size_t ws_size, hipStream_t stream) {
  static int grid_blocks = 0;
  if (!grid_blocks) {
    int dev = 0, cus = 0, per_cu = 0;
    (void)hipGetDevice(&dev);
    (void)hipDeviceGetAttribute(&cus, hipDeviceAttributeMultiprocessorCount, dev);
    (void)hipOccupancyMaxActiveBlocksPerMultiprocessor(&per_cu, mega_kernel, NTHREADS, 0);
    if (per_cu > 1) per_cu = 1;
    if (per_cu < 1) per_cu = 1;
    grid_blocks = cus * per_cu;
  }
  KArgs a{};
  for (int i = 0; i < 22; ++i) a.in[i] = (const float*)d_in[i];
  a.out = (float*)d_out;
  a.ws = (unsigned char*)d_ws;
  if (OFF_END > ws_size) fprintf(stderr, "workspace too small: need %zu have %zu\n", (size_t)OFF_END, ws_size);
  void* args[] = {&a};
  hipError_t e = hipLaunchCooperativeKernel((void*)mega_kernel, dim3(grid_blocks), dim3(NTHREADS), args, 0, stream);
  if (e != hipSuccess) fprintf(stderr, "cooperative launch failed: %s (grid %d)\n", hipGetErrorString(e), grid_blocks);
}
```

```cpp
#include <hip/hip_runtime.h>
#include <hip/hip_cooperative_groups.h>
#include <cstdio>
#include <cstdint>
namespace cg = cooperative_groups;

typedef _Float16 h16;
typedef h16 h16x8 __attribute__((ext_vector_type(8)));
typedef h16 h16x4 __attribute__((ext_vector_type(4)));
typedef float f32x16 __attribute__((ext_vector_type(16)));
typedef float f32x4 __attribute__((ext_vector_type(4)));
typedef unsigned u32x4 __attribute__((ext_vector_type(4)));

#define DM 1024
#define NBATCH 16
#define SEQ 2048
#define LCTX 256
#define NLAT 32768
#define NCTX 4096
#define NTOK 36864
#define ZC 2560
#define DFF 2816
#define NKEY 2304
#define EPS 1e-6f
#define NTHREADS 512
#define NWAVES 8
#define LDS_BYTES 131072
#define LDS_STAGE 65536

struct Params {
  const float *x, *c, *ctx, *c_ctx, *w_ada, *b_ada, *w_in, *gm_ws;
  const float *lq1, *lk1, *lq2, *lk2, *w_out, *w_up, *w_down;
  const float *g1_in, *g2_in, *gm_bs_in, *sc_w_in, *subln_in, *ffn_conv_in, *final_g_in;
  const float *g1, *g2, *gm_bs, *sc_w, *subln, *ffn_conv, *final_g;
  float* out;
  float* mod; float* lam; float* rope; float* Xc; const h16* zero; unsigned* bar;
  h16 *WinT, *WoutT, *WupT, *WdownT, *Ws16, *Fn, *Fc;
  h16 *H16;
  h16 *U16, *VTl, *VTc, *ZB, *GTl, *GTc, *Q16, *K16, *VT16, *ACT;
};
struct KArgs { const float* in[22]; float* out; unsigned char* ws; };

constexpr size_t al256(size_t x) { return (x + 255) & ~(size_t)255; }
constexpr size_t OFF_MOD = 0;
constexpr size_t OFF_LAM = OFF_MOD + al256((size_t)2 * 17 * 6144 * 4);
constexpr size_t OFF_ROPE = OFF_LAM + 256;
constexpr size_t OFF_SMALL = OFF_ROPE + al256((size_t)2048 * 32 * 4);
constexpr size_t OFF_ZERO = OFF_SMALL + al256((size_t)32768 * 4);
constexpr size_t OFF_BAR = OFF_ZERO + 8192;
constexpr size_t OFF_XC = OFF_BAR + 1024;
constexpr size_t OFF_WINT = OFF_XC + al256((size_t)NCTX * 1024 * 4);
constexpr size_t OFF_WOUTT = OFF_WINT + al256((size_t)2 * ZC * 1024 * 2);
constexpr size_t OFF_WUPT = OFF_WOUTT + al256((size_t)2 * 1024 * 1024 * 2);
constexpr size_t OFF_WDOWNT = OFF_WUPT + al256((size_t)2 * 5632 * 1024 * 2);
constexpr size_t OFF_WS16 = OFF_WDOWNT + al256((size_t)2 * 1024 * DFF * 2);
constexpr size_t OFF_FN = OFF_WS16 + al256((size_t)2 * 4 * 128 * 128 * 2);
constexpr size_t OFF_FC = OFF_FN + al256((size_t)2048 * 4096 * 2);
constexpr size_t OFF_H16 = OFF_FC + al256((size_t)256 * 512 * 2);
constexpr size_t OFF_ACT = OFF_H16 + al256((size_t)NTOK * 1024 * 2);
constexpr size_t OFF_END = OFF_ACT + al256((size_t)NTOK * DFF * 2);
constexpr size_t OFF_U16 = OFF_ACT;
constexpr size_t OFF_VTL = OFF_U16 + al256((size_t)NTOK * 256 * 2);
constexpr size_t OFF_VTC = OFF_VTL + al256((size_t)4 * 1024 * 2048 * 2);
constexpr size_t OFF_ZB = OFF_VTC + al256((size_t)4 * 1024 * 256 * 2);
constexpr size_t OFF_GTL = OFF_ZB + al256((size_t)NTOK * 768 * 2);
constexpr size_t OFF_GTC = OFF_GTL + al256((size_t)4096 * 4096 * 2);
constexpr size_t OFF_Q16 = OFF_GTC + al256((size_t)4096 * 512 * 2);
constexpr size_t OFF_K16 = OFF_Q16 + al256((size_t)NTOK * 256 * 2);
constexpr size_t OFF_VT16 = OFF_K16 + al256((size_t)NBATCH * NKEY * 256 * 2);
constexpr size_t OFF_REGION_END = OFF_VT16 + al256((size_t)NBATCH * 256 * NKEY * 2);
static_assert(OFF_REGION_END <= OFF_END, "P1 outputs overflow the ACT region");
#define SM_G1 0
#define SM_G2 2048
#define SM_GMBS 4096
#define SM_SCW 5120
#define SM_SUBLN 6656
#define SM_FFNCONV 6784
#define SM_FINALG 23680
#define SM_TOTAL 24704

__device__ __forceinline__ Params make_params(const KArgs& a) {
  Params p;
  p.x = a.in[0]; p.c = a.in[1]; p.ctx = a.in[2]; p.c_ctx = a.in[3]; p.w_ada = a.in[4]; p.b_ada = a.in[5];
  p.g1_in = a.in[6]; p.g2_in = a.in[7]; p.w_in = a.in[8]; p.gm_ws = a.in[9]; p.gm_bs_in = a.in[10]; p.sc_w_in = a.in[11];
  p.lq1 = a.in[12]; p.lk1 = a.in[13]; p.lq2 = a.in[14]; p.lk2 = a.in[15]; p.subln_in = a.in[16]; p.w_out = a.in[17];
  p.w_up = a.in[18]; p.ffn_conv_in = a.in[19]; p.w_down = a.in[20]; p.final_g_in = a.in[21];
  p.out = a.out;
  unsigned char* w = a.ws;
  const float* sm = (const float*)(w + OFF_SMALL);
  p.g1 = sm + SM_G1; p.g2 = sm + SM_G2; p.gm_bs = sm + SM_GMBS; p.sc_w = sm + SM_SCW; p.subln = sm + SM_SUBLN;
  p.ffn_conv = sm + SM_FFNCONV; p.final_g = sm + SM_FINALG;
  p.mod = (float*)(w + OFF_MOD); p.lam = (float*)(w + OFF_LAM); p.rope = (float*)(w + OFF_ROPE); p.Xc = (float*)(w + OFF_XC); p.zero = (const h16*)(w + OFF_ZERO); p.bar = (unsigned*)(w + OFF_BAR);
  p.WinT = (h16*)(w + OFF_WINT); p.WoutT = (h16*)(w + OFF_WOUTT); p.WupT = (h16*)(w + OFF_WUPT); p.WdownT = (h16*)(w + OFF_WDOWNT);
  p.Ws16 = (h16*)(w + OFF_WS16); p.Fn = (h16*)(w + OFF_FN); p.Fc = (h16*)(w + OFF_FC); p.H16 = (h16*)(w + OFF_H16);
  p.ACT = (h16*)(w + OFF_ACT); p.U16 = (h16*)(w + OFF_U16); p.VTl = (h16*)(w + OFF_VTL); p.VTc = (h16*)(w + OFF_VTC);
  p.ZB = (h16*)(w + OFF_ZB); p.GTl = (h16*)(w + OFF_GTL); p.GTc = (h16*)(w + OFF_GTC); p.Q16 = (h16*)(w + OFF_Q16);
  p.K16 = (h16*)(w + OFF_K16); p.VT16 = (h16*)(w + OFF_VT16);
  return p;
}

__device__ __forceinline__ float gelu_f(float x) {
  const float u = 0.7978845608028654f * (x + 0.044715f * x * x * x);
  return x * __builtin_amdgcn_rcpf(1.f + __expf(-2.f * u));
}
__device__ __forceinline__ float silu_f(float x) { return x * __builtin_amdgcn_rcpf(1.f + __expf(-x)); }
__device__ __forceinline__ h16x4 pack4(float a, float b, float c, float d) {
  h16x4 r; r[0] = (h16)a; r[1] = (h16)b; r[2] = (h16)c; r[3] = (h16)d; return r;
}
#define LAS __attribute__((address_space(3)))
__device__ __forceinline__ int opaque_tid() { int t = threadIdx.x; asm volatile("" : "+v"(t)); return t; }
__device__ __forceinline__ float ldvol(const float* p) { return *(const volatile float*)p; }

template <typename ARowFn>
__device__ __forceinline__ void gemm256(f32x4 (&acc)[8][4], ARowFn arow, const h16* Bt, const int ldb, const int K,
                                        unsigned char* smem, const int tid) {
  const int lane = tid & 63, wid = tid >> 6, wm = wid >> 2, wn = wid & 3;
  const int l15 = lane & 15, g4 = lane >> 4;
  const int lr = tid >> 3, lc = tid & 7;
  const h16* ap[4]; const h16* bp[4];
#pragma unroll
  for (int i = 0; i < 4; ++i) {
    const int r = lr + 64 * i;
    const int gc = (lc ^ ((r >> 1) & 7)) * 8;
    ap[i] = arow(r) + gc;
    bp[i] = Bt + (size_t)r * ldb + gc;
  }
#pragma unroll
  for (int mi = 0; mi < 8; ++mi)
#pragma unroll
    for (int nj = 0; nj < 4; ++nj)
#pragma unroll
      for (int r = 0; r < 4; ++r) acc[mi][nj][r] = 0.f;
  const int nk = K >> 6;
  const int sw = (l15 >> 1) & 7;
  const int arow0 = (wm * 128 + l15) * 128, brow0 = (wn * 64 + l15) * 128;
  LAS unsigned char* lds = (LAS unsigned char*)smem;
  const int wbase = __builtin_amdgcn_readfirstlane(wid) * 1024;
  const int half = __builtin_amdgcn_readfirstlane(wid >> 2);
#define G256_ISSUE(kt) do { const int so_ = ((kt) & 1) * LDS_STAGE;                                                      \
    _Pragma("unroll") for (int i = 0; i < 4; ++i) {                                                                      \
      __builtin_amdgcn_global_load_lds((const unsigned*)(ap[i] + (kt) * 64), (LAS unsigned*)(lds + so_ + wbase + i * 8192), 16, 0, 0); \
      __builtin_amdgcn_global_load_lds((const unsigned*)(bp[i] + (kt) * 64), (LAS unsigned*)(lds + so_ + 32768 + wbase + i * 8192), 16, 0, 0); } } while (0)
  __syncthreads();
  G256_ISSUE(0);
  asm volatile("s_waitcnt vmcnt(0)" ::: "memory");
  __syncthreads();
  if (nk > 1) G256_ISSUE(1);
#define G256_BAR() do { __builtin_amdgcn_sched_barrier(0); asm volatile("s_waitcnt lgkmcnt(0)" ::: "memory"); __builtin_amdgcn_s_barrier(); asm volatile("" ::: "memory"); __builtin_amdgcn_sched_barrier(0); } while (0)
#define G256_LOADQ(F_A, F_B, SUB, PART) do {                                                                           \
    const int ch = ((((SUB) * 4) + g4) ^ sw) << 4;                                                                      \
    _Pragma("unroll") for (int mi = 4 * (PART); mi < 4 * (PART) + 4; ++mi) F_A[mi] = *(const h16x8*)(As + arow0 + mi * 16 * 128 + ch); \
    if ((PART) == 0) { _Pragma("unroll") for (int nj = 0; nj < 4; ++nj) F_B[nj] = *(const h16x8*)(Bs + brow0 + nj * 16 * 128 + ch); } } while (0)
#define G256_MMAQ(F_A, F_B, PART) do {                                                                                  \
    _Pragma("unroll") for (int mi = 4 * (PART); mi < 4 * (PART) + 4; ++mi)                                              \
      _Pragma("unroll") for (int nj = 0; nj < 4; ++nj)                                                                  \
        acc[mi][nj] = __builtin_amdgcn_mfma_f32_16x16x32_f16(F_B[nj], F_A[mi], acc[mi][nj], 0, 0, 0); } while (0)
  if (half == 1) G256_BAR();
  for (int t = 0; t < nk; ++t) {
    const unsigned char* As = smem + (t & 1) * LDS_STAGE;
    const unsigned char* Bs = As + 32768;
    {
      if (half == 0 && t >= 1 && t + 1 < nk) G256_ISSUE(t + 1);
      h16x8 fa[8], fb[4];
      G256_LOADQ(fa, fb, 0, 0);
      G256_BAR();
      G256_MMAQ(fa, fb, 0);
      G256_BAR();
      G256_LOADQ(fa, fb, 0, 1);
      G256_BAR();
      G256_MMAQ(fa, fb, 1);
      G256_BAR();
    }
    {
      h16x8 fa[8], fb[4];
      G256_LOADQ(fa, fb, 1, 0);
      G256_BAR();
      G256_MMAQ(fa, fb, 0);
      G256_BAR();
      G256_LOADQ(fa, fb, 1, 1);
      if (half == 1 && t + 1 < nk) asm volatile("s_waitcnt vmcnt(0)" ::: "memory");
      G256_BAR();
      if (half == 1 && t + 2 < nk) G256_ISSUE(t + 2);
      G256_MMAQ(fa, fb, 1);
      if (half == 0 && t + 1 < nk) asm volatile("s_waitcnt vmcnt(0)" ::: "memory");
      G256_BAR();
    }
  }
  if (half == 0) G256_BAR();
#undef G256_BAR
#undef G256_LOADQ
#undef G256_MMAQ
#undef G256_ISSUE
  __syncthreads();
}

template <typename ColMap>
__device__ __forceinline__ void transpose_strip(const float* W, int ldw, int k0, h16* dst, int ldt, int n0, ColMap cmap,
                                                unsigned char* smem, const int tid) {
  float* tile = (float*)smem;
  __syncthreads();
  {
    const int nl = tid & 63, kq = tid >> 6;
    float v[4][8];
#pragma unroll
    for (int s = 0; s < 4; ++s) {
      const int sc = cmap(n0 + s * 64 + nl);
#pragma unroll
      for (int t = 0; t < 8; ++t) v[s][t] = W[(size_t)(k0 + kq * 8 + t) * ldw + sc];
    }
#pragma unroll
    for (int s = 0; s < 4; ++s)
#pragma unroll
      for (int t = 0; t < 8; ++t) tile[(kq * 8 + t) * 257 + s * 64 + nl] = v[s][t];
  }
  __syncthreads();
  {
    const int n = tid >> 1, ks = (tid & 1) * 32;
    h16* d = dst + (size_t)(n0 + n) * ldt + k0 + ks;
#pragma unroll
    for (int c = 0; c < 4; ++c) {
      h16x8 o;
#pragma unroll
      for (int t = 0; t < 8; ++t) o[t] = (h16)tile[(ks + c * 8 + t) * 257 + n];
      *(h16x8*)(d + c * 8) = o;
    }
  }
}

__device__ void prep_phase(const Params& p, unsigned char* smem, unsigned* queue) {
  const int nA = 192, nB = 256, nC = 128, nD = 128, nE = 704, nF = 352, nG = 2048, nH = 256, nI = 16, nJ = 4, nS = 49, nK = 1;
  const int total = nA + nB + nC + nD + nE + nF + nG + nH + nI + nJ + nS + nK;
  for (int it0 = blockIdx.x; it0 < total; it0 += gridDim.x) {
    const int tid = opaque_tid();
    int it = total - 1 - it0;
    if (it < nA) {
      const int l = it / 96, col0 = (it % 96) * 64;
      float* sv = (float*)smem;
      float* red = sv + 17 * 256;
      const int j = tid & 63, kg = tid >> 6;
      float acc[17];
#pragma unroll
      for (int i = 0; i < 17; ++i) acc[i] = 0.f;
      for (int kc = 0; kc < 4; ++kc) {
        __syncthreads();
        for (int e = tid; e < 17 * 256; e += NTHREADS) {
          const int i = e >> 8, kk = e & 255;
          const float cv = (i < 16) ? p.c[i * 1024 + kc * 256 + kk] : p.c_ctx[kc * 256 + kk];
          sv[e] = silu_f(cv);
        }
        __syncthreads();
        const float* wp = p.w_ada + ((size_t)l * 1024 + kc * 256 + kg * 32) * 6144 + col0 + j;
#pragma unroll 8
        for (int t = 0; t < 32; ++t) {
          const float w = wp[(size_t)t * 6144];
#pragma unroll
          for (int i = 0; i < 17; ++i) acc[i] += sv[i * 256 + kg * 32 + t] * w;
        }
      }
      __syncthreads();
#pragma unroll
      for (int i = 0; i < 17; ++i) red[(kg * 17 + i) * 64 + j] = acc[i];
      __syncthreads();
      for (int e = tid; e < 17 * 64; e += NTHREADS) {
        const int i = e >> 6, jj = e & 63;
        float s = 0.f;
#pragma unroll
        for (int g = 0; g < 8; ++g) s += red[(g * 17 + i) * 64 + jj];
        p.mod[(size_t)(l * 17 + i) * 6144 + col0 + jj] = s + p.b_ada[l * 6144 + col0 + jj];
      }
      __syncthreads();
      continue;
    }
    it -= nA;
    if (it < nB) {
      const int l = it / 128, r = it % 128, kt = r / 8; int ns = r % 8; if (ns >= 5) ns += 2;
      transpose_strip(p.w_in + (size_t)l * 1024 * 2304, 2304, kt * 64, p.WinT + (size_t)l * ZC * 1024, 1024, ns * 256,
                      [](int n) { return n < 1280 ? n : n - 256; }, smem, tid);
      continue;
    }
    it -= nB;
    if (it < nC) {
      const int l = it / 64, r = it % 64, h = r / 16, k0 = (r % 16) * 64;
      float* tile = (float*)smem;
      float* ct = tile + 64 * 65;
      float* st = ct + 64;
      __syncthreads();
      {
        const int nl = tid & 63, kq = tid >> 6;
        const float* W = p.w_in + (size_t)l * 1024 * 2304;
#pragma unroll
        for (int t = 0; t < 8; ++t) {
          const int k = kq * 8 + t;
          tile[k * 65 + nl] = W[(size_t)(k0 + k) * 2304 + 1280 + h * 64 + nl];
        }
        if (tid < 64) { ct[tid] = cospif((float)tid / 32.f) * 0.125f; st[tid] = sinpif((float)tid / 32.f) * 0.125f; }
      }
      __syncthreads();
      {
        const int k2 = tid & 63, kq = tid >> 6;
        h16* dc = p.WinT + ((size_t)l * ZC + 1280 + h * 64 + k2) * 1024 + k0;
        h16* ds = p.WinT + ((size_t)l * ZC + 1536 + h * 64 + k2) * 1024 + k0;
        for (int t = 0; t < 8; ++t) {
          const int k = kq * 8 + t;
          float ac = 0.f, as = 0.f;
#pragma unroll 8
          for (int d = 0; d < 64; ++d) {
            const float w = tile[k * 65 + d];
            const int idx = (k2 * d) & 63;
            ac += w * ct[idx]; as += w * st[idx];
          }
          dc[k] = (h16)ac; ds[k] = (h16)as;
        }
      }
      __syncthreads();
      continue;
    }
    it -= nC;
    if (it < nD) {
      const int l = it / 64, r = it % 64, kt = r / 4, ns = r % 4;
      transpose_strip(p.w_out + (size_t)l * 1024 * 1024, 1024, kt * 64, p.WoutT + (size_t)l * 1024 * 1024, 1024, ns * 256,
                      [](int n) { return n; }, smem, tid);
      continue;
    }
    it -= nD;
    if (it < nE) {
      const int l = it / 352, r = it % 352, kt = r / 22, ns = r % 22;
      transpose_strip(p.w_up + (size_t)l * 1024 * 5632, 5632, kt * 64, p.WupT + (size_t)l * 5632 * 1024, 1024, ns * 256,
                      [](int n) { const int t = n >> 8, cc = n & 255; const int j = t * 128 + (cc >> 6) * 32 + ((cc >> 5) & 1) * 16 + (cc & 15);
                                  return ((cc >> 4) & 1) ? DFF + j : j; }, smem, tid);
      continue;
    }
    it -= nE;
    if (it < nF) {
      const int l = it / 176, r = it % 176, kt = r / 4, ns = r % 4;
      transpose_strip(p.w_down + (size_t)l * DFF * 1024, 1024, kt * 64, p.WdownT + (size_t)l * 1024 * DFF, DFF, ns * 256,
                      [](int n) { return n; }, smem, tid);
      continue;
    }
    it -= nF;
    if (it < nG) {
      const int k1 = it;
      const float sc = 0.02209708691207961f;
      h16x8 v0;
#pragma unroll
      for (int e = 0; e < 8; ++e) {
        const int kk = tid * 8 + e;
        const int n = kk & 2047;
        const int m = (k1 * n) & 2047;
        const float a = (float)m / 1024.f;
        v0[e] = (h16)((kk < 2048) ? cospif(a) * sc : -sinpif(a) * sc);
      }
      *(h16x8*)(p.Fn + (size_t)k1 * 4096 + tid * 8) = v0;
      continue;
    }
    it -= nG;
    if (it < nH) {
      const int k1 = it;
      const int kk = tid;
      const int n = kk & 255;
      const int m = (k1 * n) & 255;
      const float a = (float)m / 128.f;
      p.Fc[(size_t)k1 * 512 + kk] = (h16)((kk < 256) ? cospif(a) * 0.0625f : -sinpif(a) * 0.0625f);
      continue;
    }
    it -= nH;
    if (it < nI) {
      const int base = it * 8192 + tid * 16;
#pragma unroll
      for (int e = 0; e < 16; ++e) p.Ws16[base + e] = (h16)p.gm_ws[base + e];
      continue;
    }
    it -= nI;
    if (it < nJ) {
      const int n = it * 512 + tid;
      const float row = (float)(n >> 6), col = (float)(n & 63);
      float* d = p.rope + (size_t)n * 32;
#pragma unroll
      for (int i = 0; i < 8; ++i) {
        const float invf = powf(10000.f, -(float)(2 * i) / 16.f);
        const float ar = row * invf, ac = col * invf;
        d[i] = cosf(ar); d[8 + i] = sinf(ar); d[16 + i] = cosf(ac); d[24 + i] = sinf(ac);
      }
      continue;
    }
    it -= nJ;
    if (it < nS) {
      const int idx = it * 512 + tid;
      if (idx < SM_TOTAL) {
        float v;
        if (idx < SM_G2) v = p.g1_in[idx - SM_G1];
        else if (idx < SM_GMBS) v = p.g2_in[idx - SM_G2];
        else if (idx < SM_SCW) v = p.gm_bs_in[idx - SM_GMBS];
        else if (idx < SM_SUBLN) v = p.sc_w_in[idx - SM_SCW];
        else if (idx < SM_FFNCONV) v = p.subln_in[idx - SM_SUBLN];
        else if (idx < SM_FINALG) v = p.ffn_conv_in[idx - SM_FFNCONV];
        else v = p.final_g_in[idx - SM_FINALG];
        ((float*)p.g1)[idx] = v;
      }
      continue;
    }
    it -= nS;
    {
      for (int e = tid; e < 2048; e += NTHREADS) ((unsigned*)p.zero)[e] = 0u;
      if (tid < 2) {
        const int l = tid;
        float s1 = 0.f, s2 = 0.f;
        for (int i = 0; i < 32; ++i) { s1 += p.lq1[l * 32 + i] * p.lk1[l * 32 + i]; s2 += p.lq2[l * 32 + i] * p.lk2[l * 32 + i]; }
        const float lam_init = 0.8f - 0.6f * expf(-0.3f * (float)l);
        p.lam[l] = expf(s1) - expf(s2) + lam_init;
        p.lam[2 + l] = lam_init;
      }
    }
  }
}

__device__ __forceinline__ float wave_sum(float v) {
#pragma unroll
  for (int o = 32; o >= 1; o >>= 1) v += __shfl_xor(v, o);
  return v;
}

__device__ void norm_phase(const Params& p, int l, int which  , bool from_input, int nrows) {
  const int tid_ = opaque_tid(); const int lane = tid_ & 63, wid = tid_ >> 6;
  const float* gv = (which == 0 ? p.g1 : p.g2) + l * 1024;
  const int sh_off = which == 0 ? 0 : 3072, sc_off = which == 0 ? 1024 : 4096;
  for (int row = blockIdx.x * NWAVES + wid; row < nrows; row += gridDim.x * NWAVES) {
    const float* xr;
    if (row < NLAT) xr = (from_input ? p.x : p.out) + (size_t)row * 1024;
    else xr = (from_input ? p.ctx : p.Xc) + (size_t)(row - NLAT) * 1024;
    f32x4 v[4];
    float ss = 0.f;
#pragma unroll
    for (int i = 0; i < 4; ++i) {
      v[i] = *(const f32x4*)(xr + i * 256 + lane * 4);
      ss += v[i][0] * v[i][0] + v[i][1] * v[i][1] + v[i][2] * v[i][2] + v[i][3] * v[i][3];
    }
    ss = wave_sum(ss);
    const float rstd = rsqrtf(ss * (1.f / 1024.f) + EPS);
    const int mi = row < NLAT ? (row >> 11) : 16;
    const float* md = p.mod + (size_t)(l * 17 + mi) * 6144;
#pragma unroll
    for (int i = 0; i < 4; ++i) {
      const int k = i * 256 + lane * 4;
      const f32x4 g = *(const f32x4*)(gv + k), sc = *(const f32x4*)(md + sc_off + k), sh = *(const f32x4*)(md + sh_off + k);
      float y[4];
#pragma unroll
      for (int e = 0; e < 4; ++e) y[e] = v[i][e] * rstd * g[e] * (1.f + sc[e]) + sh[e];
      *(h16x4*)(p.H16 + (size_t)row * 1024 + k) = pack4(y[0], y[1], y[2], y[3]);
    }
  }
}

__device__ void final_norm_phase(const Params& p) {
  const int tid_ = opaque_tid(); const int lane = tid_ & 63, wid = tid_ >> 6;
  for (int row = blockIdx.x * NWAVES + wid; row < NLAT; row += gridDim.x * NWAVES) {
    float* xr = p.out + (size_t)row * 1024;
    f32x4 v[4];
    float ss = 0.f;
#pragma unroll
    for (int i = 0; i < 4; ++i) {
      v[i] = *(const f32x4*)(xr + i * 256 + lane * 4);
      ss += v[i][0] * v[i][0] + v[i][1] * v[i][1] + v[i][2] * v[i][2] + v[i][3] * v[i][3];
    }
    ss = wave_sum(ss);
    const float rstd = rsqrtf(ss * (1.f / 1024.f) + EPS);
#pragma unroll
    for (int i = 0; i < 4; ++i) {
      const int k = i * 256 + lane * 4;
      const f32x4 g = *(const f32x4*)(p.final_g + k);
      f32x4 y;
#pragma unroll
      for (int e = 0; e < 4; ++e) y[e] = v[i][e] * rstd * g[e];
      *(f32x4*)(xr + k) = y;
    }
  }
}

__device__ __forceinline__ void rope16(f32x4& a, const float* tab, const int g4, const bool on) {
  f32x4 pr;
#pragma unroll
  for (int e = 0; e < 4; ++e) pr[e] = __shfl_xor(a[e], 32);
  if (on) {
    const f32x4 c = *(const f32x4*)(tab), s = *(const f32x4*)(tab + 8);
#pragma unroll
    for (int e = 0; e < 4; ++e) a[e] = (g4 < 2) ? (a[e] * c[e] - pr[e] * s[e]) : (a[e] * c[e] + pr[e] * s[e]);
  }
}

__device__ __forceinline__ int vblock() { return (blockIdx.x & 7) * (gridDim.x >> 3) + (blockIdx.x >> 3); }
__device__ __forceinline__ void tile_map(int it, int nMt, int nNt, int PM, int& mt, int& nt) {
  const int per = PM * nNt;
  const int panel = it / per, rem = it - panel * per, m0 = panel * PM;
  const int pmw = (nMt - m0) < PM ? (nMt - m0) : PM;
  nt = rem / pmw; mt = m0 + rem % pmw;
}
#define TID_DECL const int tid = opaque_tid(), lane = tid & 63, wid = tid >> 6, wm = wid >> 2, wn = wid & 3, l15 = lane & 15, g4 = lane >> 4;

__device__ void p1_phase(const Params& p, int l, unsigned char* smem) {
  const h16* WT = p.WinT + (size_t)l * ZC * 1024;
  const int nmain = (l == 0) ? 144 * 10 : 128 * 10, nextra = (l == 0) ? 0 : 32;
  for (int t = vblock(); t < nmain + nextra; t += gridDim.x) {
    TID_DECL
    int tm, tn;
    if (t < nmain) tile_map(t, (l == 0) ? 144 : 128, 10, 16, tm, tn);
    else { const int u = t - nmain; tm = 128 + (u & 15); tn = 8 + (u >> 4); }
    f32x4 acc[8][4];
    const h16* Abase = p.H16 + (size_t)tm * 256 * 1024;
    gemm256(acc, [&](int i) { return Abase + (size_t)i * 1024; }, WT + (size_t)tn * 256 * 1024, 1024, 1024, smem, tid);
    const int g = tn;
    const int cgw = wn * 64 + 4 * g4;
#pragma unroll
    for (int mi = 0; mi < 8; ++mi) {
      const int R = tm * 256 + wm * 128 + mi * 16 + l15;
      const bool isctx = R >= NLAT;
      int b, pos;
      if (!isctx) { b = R >> 11; pos = R & 2047; } else { const int rc = R - NLAT; b = rc >> 8; pos = rc & 255; }
      if (g == 0) {
#pragma unroll
        for (int nj = 0; nj < 4; ++nj) {
          const f32x4& a = acc[mi][nj];
          *(h16x4*)(p.U16 + (size_t)R * 256 + cgw + nj * 16) = pack4(gelu_f(a[0]), gelu_f(a[1]), gelu_f(a[2]), gelu_f(a[3]));
        }
      } else if (g == 1) {
        float ss = 0.f;
#pragma unroll
        for (int nj = 0; nj < 4; ++nj)
#pragma unroll
          for (int e = 0; e < 4; ++e) { const float v = gelu_f(acc[mi][nj][e]); acc[mi][nj][e] = v; ss += v * v; }
        ss += __shfl_xor(ss, 16);
        ss += __shfl_xor(ss, 32);
        const float rinv = rsqrtf(ss * (1.f / 64.f) + EPS);
        const int head = wn;
        h16* base; int stride;
        if (!isctx) { base = p.VTl + ((size_t)(head * 1024 + b * 64) * 2048 + pos); stride = 2048; }
        else { base = p.VTc + ((size_t)(head * 1024 + b * 64) * 256 + pos); stride = 256; }
#pragma unroll
        for (int nj = 0; nj < 4; ++nj)
#pragma unroll
          for (int e = 0; e < 4; ++e) {
            const int d = nj * 16 + 4 * g4 + e;
            base[(size_t)d * stride] = (h16)(acc[mi][nj][e] * rinv);
          }
      } else if (g <= 4) {
#pragma unroll
        for (int nj = 0; nj < 4; ++nj) {
          const f32x4& a = acc[mi][nj];
          *(h16x4*)(p.ZB + (size_t)R * 768 + (g - 2) * 256 + cgw + nj * 16) = pack4(a[0], a[1], a[2], a[3]);
        }
      } else if (g <= 6) {
        h16* base; int stride;
        if (!isctx) { base = p.GTl + ((size_t)(b * 256 + cgw) * 4096 + (g == 6 ? 2048 : 0) + pos); stride = 4096; }
        else { base = p.GTc + ((size_t)(b * 256 + cgw) * 512 + (g == 6 ? 256 : 0) + pos); stride = 512; }
#pragma unroll
        for (int nj = 0; nj < 4; ++nj)
#pragma unroll
          for (int e = 0; e < 4; ++e) base[(size_t)(nj * 16 + e) * stride] = (h16)acc[mi][nj][e];
      } else if (g == 7) {
        const float qs = 0.17677669529663687f * 1.4426950408889634f;
#pragma unroll
        for (int nj = 0; nj < 4; ++nj) {
          rope16(acc[mi][nj], p.rope + (size_t)pos * 32 + (nj & 1) * 16 + 4 * (g4 & 1), g4, !isctx);
          const f32x4& a = acc[mi][nj];
          *(h16x4*)(p.Q16 + (size_t)R * 256 + cgw + nj * 16) = pack4(a[0] * qs, a[1] * qs, a[2] * qs, a[3] * qs);
        }
      } else if (g == 8) {
        const int key = isctx ? pos : 256 + pos;
#pragma unroll
        for (int nj = 0; nj < 4; ++nj) {
          rope16(acc[mi][nj], p.rope + (size_t)pos * 32 + (nj & 1) * 16 + 4 * (g4 & 1), g4, !isctx);
          const f32x4& a = acc[mi][nj];
          *(h16x4*)(p.K16 + ((size_t)b * NKEY + key) * 256 + cgw + nj * 16) = pack4(a[0], a[1], a[2], a[3]);
        }
      } else {
        const int key = isctx ? pos : 256 + pos;
        h16* base = p.VT16 + ((size_t)(b * 256 + cgw) * NKEY + key);
#pragma unroll
        for (int nj = 0; nj < 4; ++nj)
#pragma unroll
          for (int e = 0; e < 4; ++e) base[(size_t)(nj * 16 + e) * NKEY] = (h16)acc[mi][nj][e];
      }
    }
  }
}

__device__ void attn_unit(const Params& p, int l, int b, int h, int qrow0, int nkeys, unsigned char* smem, const int tid) {
  const int lane = tid & 63, w = tid >> 6, l31 = lane & 31, hf = lane >> 5;
  const h16* Kbase = p.K16 + (size_t)b * NKEY * 256 + h * 64;
  const h16* Vbase = p.VT16 + (size_t)(b * 256 + h * 64) * NKEY;
  const int qrow = qrow0 + w * 32 + l31;
  h16x8 qf0[2][2];
#pragma unroll
  for (int m = 0; m < 2; ++m)
#pragma unroll
    for (int s = 0; s < 2; ++s) qf0[m][s] = *(const h16x8*)(p.Q16 + (size_t)qrow * 256 + h * 64 + m * 32 + s * 16 + hf * 8);
  unsigned char* Qs = smem + 49152 + tid * 16;
  f32x16 O[2][2];
#pragma unroll
  for (int m = 0; m < 2; ++m)
#pragma unroll
    for (int dt = 0; dt < 2; ++dt)
#pragma unroll
      for (int r = 0; r < 16; ++r) O[m][dt][r] = 0.f;
  float mrun[2] = {0.f, 0.f}, lsum[2] = {0.f, 0.f};
  const int sr = tid >> 3, sc = tid & 7;
  const int gc = (sc ^ ((sr >> 1) & 7)) * 8;
  const h16* kp = Kbase + (size_t)sr * 256 + gc;
  const h16* vp = Vbase + (size_t)sr * NKEY + gc;
  LAS unsigned char* lds = (LAS unsigned char*)smem;
  const int wbase = __builtin_amdgcn_readfirstlane(w) * 1024;
  const int nt = nkeys >> 6;
#define ATT_ISSUE(kt, st) do {                                                                                           \
    __builtin_amdgcn_global_load_lds((const unsigned*)(kp + (size_t)(kt) * 64 * 256), (LAS unsigned*)(lds + (st) * 16384 + wbase), 16, 0, 0); \
    __builtin_amdgcn_global_load_lds((const unsigned*)(vp + (kt) * 64), (LAS unsigned*)(lds + (st) * 16384 + 8192 + wbase), 16, 0, 0); } while (0)
  const int ksw = (l31 >> 1) & 7;
#define ATT_QK(S, Ks_, m_, sub_) do {                                                                                    \
    const float nm_ = -mrun[m_];                                                                                         \
    _Pragma("unroll") for (int r = 0; r < 16; ++r) S[r] = nm_;                                                           \
    _Pragma("unroll") for (int s = 0; s < 2; ++s) {                                                                      \
      const int ch = (((m_) * 4 + s * 2 + hf) ^ ksw) << 4;                                                               \
      const h16x8 kf = *(const h16x8*)((Ks_) + ((sub_) * 32 + l31) * 128 + ch);                                          \
      const h16x8 qv = *(const h16x8*)(Qs + ((m_) * 2 + s) * 8192);                                                      \
      S = __builtin_amdgcn_mfma_f32_32x32x16_f16(kf, qv, S, 0, 0, 0); } } while (0)
  __syncthreads();
#pragma unroll
  for (int m = 0; m < 2; ++m)
#pragma unroll
    for (int s = 0; s < 2; ++s) *(h16x8*)(Qs + (m * 2 + s) * 8192) = qf0[m][s];
  ATT_ISSUE(0, 0);
  if (nt > 1) ATT_ISSUE(1, 1);
  asm volatile("s_waitcnt vmcnt(0)" ::: "memory");
  __syncthreads();
  f32x16 scur[2];
  ATT_QK(scur[0], smem, 0, 0);
  ATT_QK(scur[1], smem, 1, 0);
  int st = 0;
  for (int kt = 0; kt < nt; ++kt) {
    const int st1 = (st == 2) ? 0 : st + 1, st2 = (st1 == 2) ? 0 : st1 + 1;
    if (kt + 2 < nt) ATT_ISSUE(kt + 2, st2);
    const unsigned char* Kc = smem + st * 16384;
    const unsigned char* Vs = Kc + 8192;
    const unsigned char* Kn = smem + st1 * 16384;
#pragma unroll
    for (int sub = 0; sub < 2; ++sub) {
      const bool more = (sub == 0) || (kt + 1 < nt);
      const bool first = (kt == 0) && (sub == 0);
#pragma unroll
      for (int m = 0; m < 2; ++m) {
        f32x16 sn;
        if (more) { if (sub == 0) ATT_QK(sn, Kc, m, 1); else ATT_QK(sn, Kn, m, 0); }
        f32x16& s0 = scur[m];
        h16x8 pf[2];
        {
          float mx = s0[0];
#pragma unroll
          for (int r = 1; r < 16; ++r) mx = fmaxf(mx, s0[r]);
          mx = fmaxf(mx, __shfl_xor(mx, 32));
          if (__any(first || (mx > 8.f))) {
            const float delta = first ? mx : fmaxf(mx, 0.f);
            const float alpha = first ? 1.f : __builtin_amdgcn_exp2f(-delta);
            mrun[m] += delta;
            lsum[m] *= alpha;
#pragma unroll
            for (int r = 0; r < 16; ++r) s0[r] -= delta;
            if (more) {
#pragma unroll
              for (int r = 0; r < 16; ++r) sn[r] -= delta;
            }
#pragma unroll
            for (int dt = 0; dt < 2; ++dt)
#pragma unroll
              for (int r = 0; r < 16; ++r) O[m][dt][r] *= alpha;
          }
          float ps = 0.f;
#pragma unroll
          for (int r = 0; r < 16; ++r) { s0[r] = __builtin_amdgcn_exp2f(s0[r]); ps += s0[r]; }
          lsum[m] += ps;
#pragma unroll
          for (int sp = 0; sp < 2; ++sp) {
            u32x4 w0;
#pragma unroll
            for (int j = 0; j < 4; ++j)
              w0[j] = __builtin_bit_cast(unsigned, __builtin_amdgcn_cvt_pkrtz(s0[8 * sp + 2 * j], s0[8 * sp + 2 * j + 1]));
            pf[sp] = __builtin_bit_cast(h16x8, w0);
          }
        }
#pragma unroll
        for (int dt = 0; dt < 2; ++dt)
#pragma unroll
          for (int sp = 0; sp < 2; ++sp) {
            const int gA = sub * 8 + 4 * sp + hf, gB = gA + 2;
            const int vrow = (dt * 32 + l31) * 128;
            const h16x4 lo = *(const h16x4*)(Vs + vrow + ((((gA >> 1) ^ ksw) << 4) | ((gA & 1) << 3)));
            const h16x4 hi = *(const h16x4*)(Vs + vrow + ((((gB >> 1) ^ ksw) << 4) | ((gB & 1) << 3)));
            h16x8 vf;
            vf[0] = lo[0]; vf[1] = lo[1]; vf[2] = lo[2]; vf[3] = lo[3]; vf[4] = hi[0]; vf[5] = hi[1]; vf[6] = hi[2]; vf[7] = hi[3];
            O[m][dt] = __builtin_amdgcn_mfma_f32_32x32x16_f16(vf, pf[sp], O[m][dt], 0, 0, 0);
          }
        if (more) s0 = sn;
      }
    }
    asm volatile("s_waitcnt vmcnt(0)" ::: "memory");
    __syncthreads();
    st = st1;
  }
#undef ATT_ISSUE
#undef ATT_QK
  const float lam = ldvol(p.lam + l), lam_init = ldvol(p.lam + 2 + l);
  float l0 = lsum[0] + __shfl_xor(lsum[0], 32), l1 = lsum[1] + __shfl_xor(lsum[1], 32);
  const float i0 = 1.f / l0, i1 = lam / l1;
  float ss = 0.f;
#pragma unroll
  for (int dt = 0; dt < 2; ++dt)
#pragma unroll
    for (int r = 0; r < 16; ++r) { const float o = O[0][dt][r] * i0 - O[1][dt][r] * i1; O[0][dt][r] = o; ss += o * o; }
  ss += __shfl_xor(ss, 32);
  const float rinv = rsqrtf(ss * (1.f / 64.f) + EPS) * (1.f - lam_init);
  h16* orow = p.H16 + (size_t)qrow * 1024 + 768 + h * 64;
#pragma unroll
  for (int dt = 0; dt < 2; ++dt)
#pragma unroll
    for (int q = 0; q < 4; ++q) {
      const int d = dt * 32 + q * 8 + hf * 4;
      const f32x4 g = *(const f32x4*)(p.subln + l * 64 + d);
      *(h16x4*)(orow + d) = pack4(O[0][dt][4 * q] * rinv * g[0], O[0][dt][4 * q + 1] * rinv * g[1],
                                  O[0][dt][4 * q + 2] * rinv * g[2], O[0][dt][4 * q + 3] * rinv * g[3]);
    }
}

__device__ void p2_phase(const Params& p, int l, unsigned char* smem, unsigned* queue) {
  const bool ctxon = (l == 0);
  const int nDl = 80, nAl = 512, nAc = ctxon ? 64 : 0, nDc = ctxon ? 16 : 0, nGl = 256, nGc = ctxon ? 32 : 0;
  const int nBrows = ctxon ? NTOK : NLAT, nB = nBrows / 16;
  const int total = nDl + nAl + nAc + nDc + nGl + nGc + nB;
  h16* MIX = p.H16;
  int* qslot = (int*)(smem + LDS_BYTES - 16);
  for (;;) {
    TID_DECL
    __syncthreads();
    if (tid == 0) *qslot = (int)__hip_atomic_fetch_add(queue, 1u, __ATOMIC_RELAXED, __HIP_MEMORY_SCOPE_AGENT);
    __syncthreads();
    int it = *qslot;
    if (it >= total) break;
    if (it < nDl) {
      const int tm = it >> 4, tn = it & 15;
      f32x4 acc[8][4];
      const h16* Ab = p.Fn + (size_t)tm * 256 * 4096;
      gemm256(acc, [&](int i) { return Ab + (size_t)i * 4096; }, p.GTl + (size_t)tn * 256 * 4096, 4096, 4096, smem, tid);
      const int b = tn, c0 = wn * 64 + 4 * g4;
#pragma unroll
      for (int mi = 0; mi < 8; ++mi) {
        const int k1 = tm * 256 + wm * 128 + mi * 16 + l15;
        h16* o = MIX + ((size_t)b * 2048 + k1) * 1024 + 512 + c0;
#pragma unroll
        for (int nj = 0; nj < 4; ++nj) {
          const f32x4& a = acc[mi][nj];
          *(h16x4*)(o + nj * 16) = pack4(a[0], a[1], a[2], a[3]);
        }
        if (k1 >= 1 && k1 <= 768) {
          h16* om = MIX + ((size_t)b * 2048 + (2048 - k1)) * 1024 + 512 + wn * 64;
#pragma unroll
          for (int nj = 0; nj < 4; ++nj)
#pragma unroll
            for (int e = 0; e < 4; ++e) om[(64 - (nj * 16 + 4 * g4 + e)) & 63] = (h16)acc[mi][nj][e];
        }
      }
      continue;
    }
    it -= nDl;
    if (it < nAl) {
      const int qb = it & 7, h = (it >> 3) & 3, b = it >> 5;
      attn_unit(p, l, b, h, b * 2048 + qb * 256, NKEY, smem, tid);
      continue;
    }
    it -= nAl;
    if (it < nAc) {
      const int h = it & 3, b = it >> 2;
      attn_unit(p, l, b, h, NLAT + b * 256, 256, smem, tid);
      continue;
    }
    it -= nAc;
    if (it < nDc) {
      const int tn = it;
      f32x4 acc[8][4];
      gemm256(acc, [&](int i) { return p.Fc + (size_t)i * 512; }, p.GTc + (size_t)tn * 256 * 512, 512, 512, smem, tid);
      const int b = tn, c0 = wn * 64 + 4 * g4;
#pragma unroll
      for (int mi = 0; mi < 8; ++mi) {
        const int k1 = wm * 128 + mi * 16 + l15;
        h16* o = MIX + ((size_t)NLAT + b * 256 + k1) * 1024 + 512 + c0;
#pragma unroll
        for (int nj = 0; nj < 4; ++nj) {
          const f32x4& a = acc[mi][nj];
          *(h16x4*)(o + nj * 16) = pack4(a[0], a[1], a[2], a[3]);
        }
      }
      continue;
    }
    it -= nDc;
    if (it < nGl + nGc) {
      const bool isc = it >= nGl;
      int h, c, tn;
      if (!isc) { tn = it & 3; c = (it >> 2) & 15; h = it >> 6; }
      else { const int u = it - nGl; tn = u & 3; c = (u >> 2) & 1; h = u >> 3; }
      const int ldb = isc ? 256 : 2048;
      const h16* Bt = (isc ? p.VTc : p.VTl) + (size_t)(h * 1024 + tn * 256) * ldb + c * 128;
      const h16* Ab = p.Ws16 + (size_t)(l * 4 + h) * 128 * 128;
      f32x4 acc[8][4];
      gemm256(acc, [&](int i) { return i < 128 ? Ab + (size_t)i * 128 : p.zero; }, Bt, ldb, 128, smem, tid);
      if (wm == 0) {
#pragma unroll
        for (int mi = 0; mi < 8; ++mi) {
          const int pp = mi * 16 + l15;
          const float bias = p.gm_bs[(l * 4 + h) * 128 + pp];
#pragma unroll
          for (int nj = 0; nj < 4; ++nj) {
            const int ng = tn * 256 + wn * 64 + nj * 16;
            const int b = ng >> 6, d = (ng & 63) + 4 * g4;
            const size_t R = isc ? ((size_t)NLAT + b * 256 + c * 128 + pp) : ((size_t)b * 2048 + c * 128 + pp);
            const h16x4 u = *(const h16x4*)(p.U16 + R * 256 + h * 64 + d);
            const f32x4& a = acc[mi][nj];
            *(h16x4*)(MIX + R * 1024 + h * 64 + d) =
                pack4((a[0] + bias) * (float)u[0], (a[1] + bias) * (float)u[1], (a[2] + bias) * (float)u[2], (a[3] + bias) * (float)u[3]);
          }
        }
      }
      continue;
    }
    it -= nGl + nGc;
    {
      const int R = it * 16 + (tid >> 5);
      const int j0 = (tid & 31) * 8;
      int pos, len;
      if (R < NLAT) { pos = R & 2047; len = 2048; } else { pos = (R - NLAT) & 255; len = 256; }
      const h16* zr = p.ZB + (size_t)R * 768;
      float P[3][8];
#pragma unroll
      for (int dlt = 0; dlt < 3; ++dlt) {
        const int pp = pos + dlt - 1;
        if (pp >= 0 && pp < len) {
          const h16x8 bx = *(const h16x8*)(zr + (dlt - 1) * 768 + j0);
          const h16x8 bc = *(const h16x8*)(zr + (dlt - 1) * 768 + 512 + j0);
#pragma unroll
          for (int e = 0; e < 8; ++e) P[dlt][e] = (float)bx[e] * (float)bc[e];
        } else {
#pragma unroll
          for (int e = 0; e < 8; ++e) P[dlt][e] = 0.f;
        }
      }
      const h16x8 bb = *(const h16x8*)(zr + 256 + j0);
      const float* w = p.sc_w + l * 768 + j0;
      h16x8 o;
#pragma unroll
      for (int e = 0; e < 8; ++e)
        o[e] = (h16)((float)bb[e] * (w[e] * P[0][e] + w[256 + e] * P[1][e] + w[512 + e] * P[2][e]));
      *(h16x8*)(MIX + (size_t)R * 1024 + 256 + j0) = o;
    }
  }
}

__device__ void resid_gemm_phase(const Params& p, int l, int which  , bool from_input, int nrows,
                                 unsigned char* smem) {
  const int ntiles = (nrows / 256) * 4;
  const h16* A = which == 0 ? p.H16 : p.ACT;
  const int K = which == 0 ? 1024 : DFF;
  const h16* WT = which == 0 ? p.WoutT + (size_t)l * 1024 * 1024 : p.WdownT + (size_t)l * 1024 * DFF;
  const int goff = which == 0 ? 2048 : 5120;
  for (int t = vblock(); t < ntiles; t += gridDim.x) {
    TID_DECL
    int tm, tn;
    tile_map(t, nrows / 256, 4, 8, tm, tn);
    f32x4 acc[8][4];
    const h16* Ab = A + (size_t)tm * 256 * K;
    gemm256(acc, [&](int i) { return Ab + (size_t)i * K; }, WT + (size_t)tn * 256 * K, K, K, smem, tid);
#pragma unroll
    for (int mi = 0; mi < 8; ++mi) {
      const int R = tm * 256 + wm * 128 + mi * 16 + l15;
      const float* xin; float* xo; int mod_i;
      if (R < NLAT) { xin = (from_input ? p.x : p.out) + (size_t)R * 1024; xo = p.out + (size_t)R * 1024; mod_i = R >> 11; }
      else { xin = (from_input ? p.ctx : p.Xc) + (size_t)(R - NLAT) * 1024; xo = p.Xc + (size_t)(R - NLAT) * 1024; mod_i = 16; }
      const float* gt = p.mod + (size_t)(l * 17 + mod_i) * 6144 + goff;
#pragma unroll
      for (int nj = 0; nj < 4; ++nj) {
        const int n = tn * 256 + wn * 64 + nj * 16 + 4 * g4;
        const f32x4 xi = *(const f32x4*)(xin + n), gg = *(const f32x4*)(gt + n);
        const f32x4& a = acc[mi][nj];
        f32x4 y;
#pragma unroll
        for (int e = 0; e < 4; ++e) y[e] = xi[e] + gg[e] * a[e];
        *(f32x4*)(xo + n) = y;
      }
    }
  }
}

__device__ void p4_phase(const Params& p, int l, int nrows, unsigned char* smem) {
  const int nmt = (nrows + 253) / 254;
  const int ntiles = nmt * 22;
  const h16* WT = p.WupT + (size_t)l * 5632 * 1024;
  const float* cw = p.ffn_conv + (size_t)l * 3 * DFF;
  h16* abuf = (h16*)smem;
  for (int it = vblock(); it < ntiles; it += gridDim.x) {
    TID_DECL
    int nt, t;
    tile_map(it, nmt, 22, 16, t, nt);
    const int R0 = 254 * t - 1;
    f32x4 acc[8][4];
    gemm256(acc, [&](int i) -> const h16* { const int R = R0 + i; return (R >= 0 && R < nrows) ? p.H16 + (size_t)R * 1024 : p.zero; },
            WT + (size_t)nt * 256 * 1024, 1024, 1024, smem, tid);
#pragma unroll
    for (int mi = 0; mi < 8; ++mi) {
      const int m = wm * 128 + mi * 16 + l15;
#pragma unroll
      for (int pj = 0; pj < 2; ++pj)
        *(h16x4*)(abuf + m * 136 + wn * 32 + pj * 16 + 4 * g4) =
            pack4(acc[mi][2 * pj][0], acc[mi][2 * pj][1], acc[mi][2 * pj][2], acc[mi][2 * pj][3]);
    }
    __syncthreads();
#pragma unroll
    for (int mi = 0; mi < 8; ++mi) {
      const int m = wm * 128 + mi * 16 + l15;
      const int R = R0 + m;
      if (m >= 1 && m <= 254 && R < nrows) {
        int ps, len;
        if (R < NLAT) { ps = R & 2047; len = 2048; } else { ps = (R - NLAT) & 255; len = 256; }
        const float mp = (ps == 0) ? 0.f : 1.f, mn = (ps == len - 1) ? 0.f : 1.f;
#pragma unroll
        for (int pj = 0; pj < 2; ++pj) {
          const int ja = wn * 32 + pj * 16 + 4 * g4;
          const int j = nt * 128 + ja;
          const h16x4 ap = *(const h16x4*)(abuf + (m - 1) * 136 + ja), an = *(const h16x4*)(abuf + (m + 1) * 136 + ja);
          const f32x4 w0 = *(const f32x4*)(cw + j), w1 = *(const f32x4*)(cw + DFF + j), w2 = *(const f32x4*)(cw + 2 * DFF + j);
          float y[4];
#pragma unroll
          for (int e = 0; e < 4; ++e) {
            const float cv = w0[e] * mp * (float)ap[e] + w1[e] * acc[mi][2 * pj][e] + w2[e] * mn * (float)an[e];
            y[e] = silu_f(cv) * acc[mi][2 * pj + 1][e];
          }
          *(h16x4*)(p.ACT + (size_t)R * DFF + j) = pack4(y[0], y[1], y[2], y[3]);
        }
      }
    }
  }
}

__device__ __forceinline__ void grid_bar(unsigned* ctr, unsigned target) {
  asm volatile("s_waitcnt vmcnt(0) lgkmcnt(0)" ::: "memory");
  __syncthreads();
  if (threadIdx.x == 0) {
    __builtin_amdgcn_fence(__ATOMIC_RELEASE, "agent");
    asm volatile("s_waitcnt vmcnt(0)" ::: "memory");
    __hip_atomic_fetch_add(ctr, 1u, __ATOMIC_RELAXED, __HIP_MEMORY_SCOPE_AGENT);
    while (__hip_atomic_load(ctr, __ATOMIC_RELAXED, __HIP_MEMORY_SCOPE_AGENT) < target) __builtin_amdgcn_s_sleep(2);
    __builtin_amdgcn_fence(__ATOMIC_ACQUIRE, "agent");
    asm volatile("s_waitcnt vmcnt(0)" ::: "memory");
  }
  __syncthreads();
}

__global__ void __launch_bounds__(NTHREADS, 2) mega_kernel(KArgs ka) {
  __shared__ __attribute__((aligned(1024))) unsigned char smem[LDS_BYTES];
  cg::grid_group grid = cg::this_grid();
  const Params p = make_params(ka);
  if (blockIdx.x == 0 && threadIdx.x < 8) __hip_atomic_store(p.bar + threadIdx.x * 16, 0u, __ATOMIC_RELAXED, __HIP_MEMORY_SCOPE_AGENT);
  unsigned nbar = 0;
  const unsigned G = gridDim.x;
#define GBAR() do { ++nbar; grid_bar(p.bar, nbar * G); } while (0)
  prep_phase(p, smem, p.bar + 16 * 5);
  grid.sync();
  norm_phase(p, 0, 0, true, NTOK);
  GBAR();
  for (int l = 0; l < 2; ++l) {
    const bool first = (l == 0);
    const int nrows = first ? NTOK : NLAT;
    p1_phase(p, l, smem);
    GBAR();
    p2_phase(p, l, smem, p.bar + 16 * (1 + l));
    GBAR();
    resid_gemm_phase(p, l, 0, first, nrows, smem);
    GBAR();
    norm_phase(p, l, 1, false, nrows);
    GBAR();
    p4_phase(p, l, nrows, smem);
    GBAR();
    resid_gemm_phase(p, l, 1, false, nrows, smem);
    GBAR();
    if (first) { norm_phase(p, 1, 0, false, NTOK); GBAR(); }
  }
  final_norm_phase(p);
}

extern "C" void kernel_launch(void* const* d_in, const int* in_sizes, int n_in, void* d_out, int out_size, void* d_ws,
                              size_t ws_size, hipStream_t stream) {
  static int grid_blocks = 0;
  if (!grid_blocks) {
    int dev = 0, cus = 0, per_cu = 0;
    (void)hipGetDevice(&dev);
    (void)hipDeviceGetAttribute(&cus, hipDeviceAttributeMultiprocessorCount, dev);
    (void)hipOccupancyMaxActiveBlocksPerMultiprocessor(&per_cu, mega_kernel, NTHREADS, 0);
    if (per_cu > 1) per_cu = 1;
    if (per_cu < 1) per_cu = 1;
    grid_blocks = cus * per_cu;
  }
  KArgs a{};
  for (int i = 0; i < 22; ++i) a.in[i] = (const float*)d_in[i];
  a.out = (float*)d_out;
  a.ws = (unsigned char*)d_ws;
  if (OFF_END > ws_size) fprintf(stderr, "workspace too small: need %zu have %zu\n", (size_t)OFF_END, ws_size);
  void* args[] = {&a};
  hipError_t e = hipLaunchCooperativeKernel((void*)mega_kernel, dim3(grid_blocks), dim3(NTHREADS), args, 0, stream);
  if (e != hipSuccess) fprintf(stderr, "cooperative launch failed: %s (grid %d)\n", hipGetErrorString(e), grid_blocks);
}
```

```cpp
#include <hip/hip_runtime.h>
#include <hip/hip_cooperative_groups.h>
#include <cstdio>
#include <cstdint>
namespace cg = cooperative_groups;

typedef _Float16 h16;
typedef h16 h16x8 __attribute__((ext_vector_type(8)));
typedef h16 h16x4 __attribute__((ext_vector_type(4)));
typedef float f32x16 __attribute__((ext_vector_type(16)));
typedef float f32x4 __attribute__((ext_vector_type(4)));
typedef unsigned u32x4 __attribute__((ext_vector_type(4)));

#define DM 1024
#define NBATCH 16
#define SEQ 2048
#define LCTX 256
#define NLAT 32768
#define NCTX 4096
#define NTOK 36864
#define ZC 2560
#define DFF 2816
#define NKEY 2304
#define EPS 1e-6f
#define NTHREADS 512
#define NWAVES 8
#define LDS_BYTES 131072
#define LDS_STAGE 65536

struct Params {
  const float *x, *c, *ctx, *c_ctx, *w_ada, *b_ada, *w_in, *gm_ws;
  const float *lq1, *lk1, *lq2, *lk2, *w_out, *w_up, *w_down;
  const float *g1_in, *g2_in, *gm_bs_in, *sc_w_in, *subln_in, *ffn_conv_in, *final_g_in;
  const float *g1, *g2, *gm_bs, *sc_w, *subln, *ffn_conv, *final_g;
  float* out;
  float* mod; float* lam; float* rope; float* Xc; const h16* zero; unsigned* bar;
  h16 *WinT, *WoutT, *WupT, *WdownT, *Ws16, *Fn, *Fc;
  h16 *H16;
  h16 *U16, *VTl, *VTc, *ZB, *GTl, *GTc, *Q16, *K16, *VT16, *ACT;
};
struct KArgs { const float* in[22]; float* out; unsigned char* ws; };

constexpr size_t al256(size_t x) { return (x + 255) & ~(size_t)255; }
constexpr size_t OFF_MOD = 0;
constexpr size_t OFF_LAM = OFF_MOD + al256((size_t)2 * 17 * 6144 * 4);
constexpr size_t OFF_ROPE = OFF_LAM + 256;
constexpr size_t OFF_SMALL = OFF_ROPE + al256((size_t)2048 * 32 * 4);
constexpr size_t OFF_ZERO = OFF_SMALL + al256((size_t)32768 * 4);
constexpr size_t OFF_BAR = OFF_ZERO + 8192;
constexpr size_t OFF_XC = OFF_BAR + 1024;
constexpr size_t OFF_WINT = OFF_XC + al256((size_t)NCTX * 1024 * 4);
constexpr size_t OFF_WOUTT = OFF_WINT + al256((size_t)2 * ZC * 1024 * 2);
constexpr size_t OFF_WUPT = OFF_WOUTT + al256((size_t)2 * 1024 * 1024 * 2);
constexpr size_t OFF_WDOWNT = OFF_WUPT + al256((size_t)2 * 5632 * 1024 * 2);
constexpr size_t OFF_WS16 = OFF_WDOWNT + al256((size_t)2 * 1024 * DFF * 2);
constexpr size_t OFF_FN = OFF_WS16 + al256((size_t)2 * 4 * 128 * 128 * 2);
constexpr size_t OFF_FC = OFF_FN + al256((size_t)2048 * 4096 * 2);
constexpr size_t OFF_H16 = OFF_FC + al256((size_t)256 * 512 * 2);
constexpr size_t OFF_ACT = OFF_H16 + al256((size_t)NTOK * 1024 * 2);
constexpr size_t OFF_END = OFF_ACT + al256((size_t)NTOK * DFF * 2);
constexpr size_t OFF_U16 = OFF_ACT;
constexpr size_t OFF_VTL = OFF_U16 + al256((size_t)NTOK * 256 * 2);
constexpr size_t OFF_VTC = OFF_VTL + al256((size_t)4 * 1024 * 2048 * 2);
constexpr size_t OFF_ZB = OFF_VTC + al256((size_t)4 * 1024 * 256 * 2);
constexpr size_t OFF_GTL = OFF_ZB + al256((size_t)NTOK * 768 * 2);
constexpr size_t OFF_GTC = OFF_GTL + al256((size_t)4096 * 4096 * 2);
constexpr size_t OFF_Q16 = OFF_GTC + al256((size_t)4096 * 512 * 2);
constexpr size_t OFF_K16 = OFF_Q16 + al256((size_t)NTOK * 256 * 2);
constexpr size_t OFF_VT16 = OFF_K16 + al256((size_t)NBATCH * NKEY * 256 * 2);
constexpr size_t OFF_REGION_END = OFF_VT16 + al256((size_t)NBATCH * 256 * NKEY * 2);
static_assert(OFF_REGION_END <= OFF_END, "P1 outputs overflow the ACT region");
#define SM_G1 0
#define SM_G2 2048
#define SM_GMBS 4096
#define SM_SCW 5120
#define SM_SUBLN 6656
#define SM_FFNCONV 6784
#define SM_FINALG 23680
#define SM_TOTAL 24704

__device__ __forceinline__ Params make_params(const KArgs& a) {
  Params p;
  p.x = a.in[0]; p.c = a.in[1]; p.ctx = a.in[2]; p.c_ctx = a.in[3]; p.w_ada = a.in[4]; p.b_ada = a.in[5];
  p.g1_in = a.in[6]; p.g2_in = a.in[7]; p.w_in = a.in[8]; p.gm_ws = a.in[9]; p.gm_bs_in = a.in[10]; p.sc_w_in = a.in[11];
  p.lq1 = a.in[12]; p.lk1 = a.in[13]; p.lq2 = a.in[14]; p.lk2 = a.in[15]; p.subln_in = a.in[16]; p.w_out = a.in[17];
  p.w_up = a.in[18]; p.ffn_conv_in = a.in[19]; p.w_down = a.in[20]; p.final_g_in = a.in[21];
  p.out = a.out;
  unsigned char* w = a.ws;
  const float* sm = (const float*)(w + OFF_SMALL);
  p.g1 = sm + SM_G1; p.g2 = sm + SM_G2; p.gm_bs = sm + SM_GMBS; p.sc_w = sm + SM_SCW; p.subln = sm + SM_SUBLN;
  p.ffn_conv = sm + SM_FFNCONV; p.final_g = sm + SM_FINALG;
  p.mod = (float*)(w + OFF_MOD); p.lam = (float*)(w + OFF_LAM); p.rope = (float*)(w + OFF_ROPE); p.Xc = (float*)(w + OFF_XC); p.zero = (const h16*)(w + OFF_ZERO); p.bar = (unsigned*)(w + OFF_BAR);
  p.WinT = (h16*)(w + OFF_WINT); p.WoutT = (h16*)(w + OFF_WOUTT); p.WupT = (h16*)(w + OFF_WUPT); p.WdownT = (h16*)(w + OFF_WDOWNT);
  p.Ws16 = (h16*)(w + OFF_WS16); p.Fn = (h16*)(w + OFF_FN); p.Fc = (h16*)(w + OFF_FC); p.H16 = (h16*)(w + OFF_H16);
  p.ACT = (h16*)(w + OFF_ACT); p.U16 = (h16*)(w + OFF_U16); p.VTl = (h16*)(w + OFF_VTL); p.VTc = (h16*)(w + OFF_VTC);
  p.ZB = (h16*)(w + OFF_ZB); p.GTl = (h16*)(w + OFF_GTL); p.GTc = (h16*)(w + OFF_GTC); p.Q16 = (h16*)(w + OFF_Q16);
  p.K16 = (h16*)(w + OFF_K16); p.VT16 = (h16*)(w + OFF_VT16);
  return p;
}

__device__ __forceinline__ float gelu_f(float x) {
  const float u = 0.7978845608028654f * (x + 0.044715f * x * x * x);
  return x * __builtin_amdgcn_rcpf(1.f + __expf(-2.f * u));
}
__device__ __forceinline__ float silu_f(float x) { return x * __builtin_amdgcn_rcpf(1.f + __expf(-x)); }
__device__ __forceinline__ h16x4 pack4(float a, float b, float c, float d) {
  h16x4 r; r[0] = (h16)a; r[1] = (h16)b; r[2] = (h16)c; r[3] = (h16)d; return r;
}
#define LAS __attribute__((address_space(3)))
__device__ __forceinline__ int opaque_tid() { int t = threadIdx.x; asm volatile("" : "+v"(t)); return t; }
__device__ __forceinline__ float ldvol(const float* p) { return *(const volatile float*)p; }

template <typename ARowFn>
__device__ __forceinline__ void gemm256(f32x4 (&acc)[8][4], ARowFn arow, const h16* Bt, const int ldb, const int K,
                                        unsigned char* smem, const int tid) {
  const int lane = tid & 63, wid = tid >> 6, wm = wid >> 2, wn = wid & 3;
  const int l15 = lane & 15, g4 = lane >> 4;
  const int lr = tid >> 3, lc = tid & 7;
  const h16* ap[4]; const h16* bp[4];
#pragma unroll
  for (int i = 0; i < 4; ++i) {
    const int r = lr + 64 * i;
    const int gc = (lc ^ ((r >> 1) & 7)) * 8;
    ap[i] = arow(r) + gc;
    bp[i] = Bt + (size_t)r * ldb + gc;
  }
#pragma unroll
  for (int mi = 0; mi < 8; ++mi)
#pragma unroll
    for (int nj = 0; nj < 4; ++nj)
#pragma unroll
      for (int r = 0; r < 4; ++r) acc[mi][nj][r] = 0.f;
  const int nk = K >> 6;
  const int sw = (l15 >> 1) & 7;
  const int arow0 = (wm * 128 + l15) * 128, brow0 = (wn * 64 + l15) * 128;
  LAS unsigned char* lds = (LAS unsigned char*)smem;
  const int wbase = __builtin_amdgcn_readfirstlane(wid) * 1024;
  const int half = __builtin_amdgcn_readfirstlane(wid >> 2);
#define G256_ISSUE(kt) do { const int so_ = ((kt) & 1) * LDS_STAGE;                                                      \
    _Pragma("unroll") for (int i = 0; i < 4; ++i) {                                                                      \
      __builtin_amdgcn_global_load_lds((const unsigned*)(ap[i] + (kt) * 64), (LAS unsigned*)(lds + so_ + wbase + i * 8192), 16, 0, 0); \
      __builtin_amdgcn_global_load_lds((const unsigned*)(bp[i] + (kt) * 64), (LAS unsigned*)(lds + so_ + 32768 + wbase + i * 8192), 16, 0, 0); } } while (0)
#define G256_ISSUE_PART(kt, i) do { const int so_ = ((kt) & 1) * LDS_STAGE;                                              \
    __builtin_amdgcn_global_load_lds((const unsigned*)(ap[i] + (kt) * 64), (LAS unsigned*)(lds + so_ + wbase + (i) * 8192), 16, 0, 0); \
    __builtin_amdgcn_global_load_lds((const unsigned*)(bp[i] + (kt) * 64), (LAS unsigned*)(lds + so_ + 32768 + wbase + (i) * 8192), 16, 0, 0); } while (0)
  __syncthreads();
  G256_ISSUE(0);
  asm volatile("s_waitcnt vmcnt(0)" ::: "memory");
  __syncthreads();
  if (nk > 1) G256_ISSUE(1);
#define G256_BAR() do { __builtin_amdgcn_sched_barrier(0); asm volatile("s_waitcnt lgkmcnt(0)" ::: "memory"); __builtin_amdgcn_s_barrier(); asm volatile("" ::: "memory"); __builtin_amdgcn_sched_barrier(0); } while (0)
#define G256_LOADQ(F_A, F_B, SUB, PART) do {                                                                           \
    const int ch = ((((SUB) * 4) + g4) ^ sw) << 4;                                                                      \
    _Pragma("unroll") for (int mi = 4 * (PART); mi < 4 * (PART) + 4; ++mi) F_A[mi] = *(const h16x8*)(As + arow0 + mi * 16 * 128 + ch); \
    if ((PART) == 0) { _Pragma("unroll") for (int nj = 0; nj < 4; ++nj) F_B[nj] = *(const h16x8*)(Bs + brow0 + nj * 16 * 128 + ch); } } while (0)
#define G256_MMAQ(F_A, F_B, PART) do {                                                                                  \
    _Pragma("unroll") for (int mi = 4 * (PART); mi < 4 * (PART) + 4; ++mi)                                              \
      _Pragma("unroll") for (int nj = 0; nj < 4; ++nj)                                                                  \
        acc[mi][nj] = __builtin_amdgcn_mfma_f32_16x16x32_f16(F_B[nj], F_A[mi], acc[mi][nj], 0, 0, 0); } while (0)
  if (half == 1) G256_BAR();
  for (int t = 0; t < nk; ++t) {
    const unsigned char* As = smem + (t & 1) * LDS_STAGE;
    const unsigned char* Bs = As + 32768;
    {
      const bool i0 = (half == 0) && t >= 1 && t + 1 < nk;
      const bool i1 = (half == 1) && t >= 1 && t + 1 < nk;
      h16x8 fa[8], fb[4];
      if (i0) G256_ISSUE_PART(t + 1, 0);
      if (i1) G256_ISSUE_PART(t + 1, 1);
      G256_LOADQ(fa, fb, 0, 0);
      G256_BAR();
      if (i0) G256_ISSUE_PART(t + 1, 1);
      if (i1) G256_ISSUE_PART(t + 1, 2);
      G256_MMAQ(fa, fb, 0);
      G256_BAR();
      if (i0) G256_ISSUE_PART(t + 1, 2);
      if (i1) G256_ISSUE_PART(t + 1, 3);
      G256_LOADQ(fa, fb, 0, 1);
      G256_BAR();
      if (i0) G256_ISSUE_PART(t + 1, 3);
      G256_MMAQ(fa, fb, 1);
      G256_BAR();
    }
    {
      h16x8 fa[8], fb[4];
      G256_LOADQ(fa, fb, 1, 0);
      G256_BAR();
      G256_MMAQ(fa, fb, 0);
      G256_BAR();
      G256_LOADQ(fa, fb, 1, 1);
      if (half == 1 && t + 1 < nk) asm volatile("s_waitcnt vmcnt(0)" ::: "memory");
      G256_BAR();
      if (half == 1 && t + 2 < nk) G256_ISSUE_PART(t + 2, 0);
      G256_MMAQ(fa, fb, 1);
      if (half == 0 && t + 1 < nk) asm volatile("s_waitcnt vmcnt(0)" ::: "memory");
      G256_BAR();
    }
  }
  if (half == 0) G256_BAR();
#undef G256_BAR
#undef G256_LOADQ
#undef G256_MMAQ
#undef G256_ISSUE
#undef G256_ISSUE_PART
  __syncthreads();
}

template <typename ColMap>
__device__ __forceinline__ void transpose_strip(const float* W, int ldw, int k0, h16* dst, int ldt, int n0, ColMap cmap,
                                                unsigned char* smem, const int tid) {
  float* tile = (float*)smem;
  __syncthreads();
  {
    const int nl = tid & 63, kq = tid >> 6;
    float v[4][8];
#pragma unroll
    for (int s = 0; s < 4; ++s) {
      const int sc = cmap(n0 + s * 64 + nl);
#pragma unroll
      for (int t = 0; t < 8; ++t) v[s][t] = W[(size_t)(k0 + kq * 8 + t) * ldw + sc];
    }
#pragma unroll
    for (int s = 0; s < 4; ++s)
#pragma unroll
      for (int t = 0; t < 8; ++t) tile[(kq * 8 + t) * 257 + s * 64 + nl] = v[s][t];
  }
  __syncthreads();
  {
    const int n = tid >> 1, ks = (tid & 1) * 32;
    h16* d = dst + (size_t)(n0 + n) * ldt + k0 + ks;
#pragma unroll
    for (int c = 0; c < 4; ++c) {
      h16x8 o;
#pragma unroll
      for (int t = 0; t < 8; ++t) o[t] = (h16)tile[(ks + c * 8 + t) * 257 + n];
      *(h16x8*)(d + c * 8) = o;
    }
  }
}

__device__ void prep_phase(const Params& p, unsigned char* smem, unsigned* queue) {
  const int nA = 192, nB = 256, nC = 128, nD = 128, nE = 704, nF = 352, nG = 2048, nH = 256, nI = 16, nJ = 4, nS = 49, nK = 1;
  const int total = nA + nB + nC + nD + nE + nF + nG + nH + nI + nJ + nS + nK;
  for (int it0 = blockIdx.x; it0 < total; it0 += gridDim.x) {
    const int tid = opaque_tid();
    int it = total - 1 - it0;
    if (it < nA) {
      const int l = it / 96, col0 = (it % 96) * 64;
      float* sv = (float*)smem;
      float* red = sv + 17 * 256;
      const int j = tid & 63, kg = tid >> 6;
      float acc[17];
#pragma unroll
      for (int i = 0; i < 17; ++i) acc[i] = 0.f;
      for (int kc = 0; kc < 4; ++kc) {
        __syncthreads();
        for (int e = tid; e < 17 * 256; e += NTHREADS) {
          const int i = e >> 8, kk = e & 255;
          const float cv = (i < 16) ? p.c[i * 1024 + kc * 256 + kk] : p.c_ctx[kc * 256 + kk];
          sv[e] = silu_f(cv);
        }
        __syncthreads();
        const float* wp = p.w_ada + ((size_t)l * 1024 + kc * 256 + kg * 32) * 6144 + col0 + j;
#pragma unroll 8
        for (int t = 0; t < 32; ++t) {
          const float w = wp[(size_t)t * 6144];
#pragma unroll
          for (int i = 0; i < 17; ++i) acc[i] += sv[i * 256 + kg * 32 + t] * w;
        }
      }
      __syncthreads();
#pragma unroll
      for (int i = 0; i < 17; ++i) red[(kg * 17 + i) * 64 + j] = acc[i];
      __syncthreads();
      for (int e = tid; e < 17 * 64; e += NTHREADS) {
        const int i = e >> 6, jj = e & 63;
        float s = 0.f;
#pragma unroll
        for (int g = 0; g < 8; ++g) s += red[(g * 17 + i) * 64 + jj];
        p.mod[(size_t)(l * 17 + i) * 6144 + col0 + jj] = s + p.b_ada[l * 6144 + col0 + jj];
      }
      __syncthreads();
      continue;
    }
    it -= nA;
    if (it < nB) {
      const int l = it / 128, r = it % 128, kt = r / 8; int ns = r % 8; if (ns >= 5) ns += 2;
      transpose_strip(p.w_in + (size_t)l * 1024 * 2304, 2304, kt * 64, p.WinT + (size_t)l * ZC * 1024, 1024, ns * 256,
                      [](int n) { return n < 1280 ? n : n - 256; }, smem, tid);
      continue;
    }
    it -= nB;
    if (it < nC) {
      const int l = it / 64, r = it % 64, h = r / 16, k0 = (r % 16) * 64;
      float* tile = (float*)smem;
      float* ct = tile + 64 * 65;
      float* st = ct + 64;
      __syncthreads();
      {
        const int nl = tid & 63, kq = tid >> 6;
        const float* W = p.w_in + (size_t)l * 1024 * 2304;
#pragma unroll
        for (int t = 0; t < 8; ++t) {
          const int k = kq * 8 + t;
          tile[k * 65 + nl] = W[(size_t)(k0 + k) * 2304 + 1280 + h * 64 + nl];
        }
        if (tid < 64) { ct[tid] = cospif((float)tid / 32.f) * 0.125f; st[tid] = sinpif((float)tid / 32.f) * 0.125f; }
      }
      __syncthreads();
      {
        const int k2 = tid & 63, kq = tid >> 6;
        h16* dc = p.WinT + ((size_t)l * ZC + 1280 + h * 64 + k2) * 1024 + k0;
        h16* ds = p.WinT + ((size_t)l * ZC + 1536 + h * 64 + k2) * 1024 + k0;
        for (int t = 0; t < 8; ++t) {
          const int k = kq * 8 + t;
          float ac = 0.f, as = 0.f;
#pragma unroll 8
          for (int d = 0; d < 64; ++d) {
            const float w = tile[k * 65 + d];
            const int idx = (k2 * d) & 63;
            ac += w * ct[idx]; as += w * st[idx];
          }
          dc[k] = (h16)ac; ds[k] = (h16)as;
        }
      }
      __syncthreads();
      continue;
    }
    it -= nC;
    if (it < nD) {
      const int l = it / 64, r = it % 64, kt = r / 4, ns = r % 4;
      transpose_strip(p.w_out + (size_t)l * 1024 * 1024, 1024, kt * 64, p.WoutT + (size_t)l * 1024 * 1024, 1024, ns * 256,
                      [](int n) { return n; }, smem, tid);
      continue;
    }
    it -= nD;
    if (it < nE) {
      const int l = it / 352, r = it % 352, kt = r / 22, ns = r % 22;
      transpose_strip(p.w_up + (size_t)l * 1024 * 5632, 5632, kt * 64, p.WupT + (size_t)l * 5632 * 1024, 1024, ns * 256,
                      [](int n) { const int t = n >> 8, cc = n & 255; const int j = t * 128 + (cc >> 6) * 32 + ((cc >> 5) & 1) * 16 + (cc & 15);
                                  return ((cc >> 4) & 1) ? DFF + j : j; }, smem, tid);
      continue;
    }
    it -= nE;
    if (it < nF) {
      const int l = it / 176, r = it % 176, kt = r / 4, ns = r % 4;
      transpose_strip(p.w_down + (size_t)l * DFF * 1024, 1024, kt * 64, p.WdownT + (size_t)l * 1024 * DFF, DFF, ns * 256,
                      [](int n) { return n; }, smem, tid);
      continue;
    }
    it -= nF;
    if (it < nG) {
      const int k1 = it;
      const float sc = 0.02209708691207961f;
      h16x8 v0;
#pragma unroll
      for (int e = 0; e < 8; ++e) {
        const int kk = tid * 8 + e;
        const int n = kk & 2047;
        const int m = (k1 * n) & 2047;
        const float a = (float)m / 1024.f;
        v0[e] = (h16)((kk < 2048) ? cospif(a) * sc : -sinpif(a) * sc);
      }
      *(h16x8*)(p.Fn + (size_t)k1 * 4096 + tid * 8) = v0;
      continue;
    }
    it -= nG;
    if (it < nH) {
      const int k1 = it;
      const int kk = tid;
      const int n = kk & 255;
      const int m = (k1 * n) & 255;
      const float a = (float)m / 128.f;
      p.Fc[(size_t)k1 * 512 + kk] = (h16)((kk < 256) ? cospif(a) * 0.0625f : -sinpif(a) * 0.0625f);
      continue;
    }
    it -= nH;
    if (it < nI) {
      const int base = it * 8192 + tid * 16;
#pragma unroll
      for (int e = 0; e < 16; ++e) p.Ws16[base + e] = (h16)p.gm_ws[base + e];
      continue;
    }
    it -= nI;
    if (it < nJ) {
      const int n = it * 512 + tid;
      const float row = (float)(n >> 6), col = (float)(n & 63);
      float* d = p.rope + (size_t)n * 32;
#pragma unroll
      for (int i = 0; i < 8; ++i) {
        const float invf = powf(10000.f, -(float)(2 * i) / 16.f);
        const float ar = row * invf, ac = col * invf;
        d[i] = cosf(ar); d[8 + i] = sinf(ar); d[16 + i] = cosf(ac); d[24 + i] = sinf(ac);
      }
      continue;
    }
    it -= nJ;
    if (it < nS) {
      const int idx = it * 512 + tid;
      if (idx < SM_TOTAL) {
        float v;
        if (idx < SM_G2) v = p.g1_in[idx - SM_G1];
        else if (idx < SM_GMBS) v = p.g2_in[idx - SM_G2];
        else if (idx < SM_SCW) v = p.gm_bs_in[idx - SM_GMBS];
        else if (idx < SM_SUBLN) v = p.sc_w_in[idx - SM_SCW];
        else if (idx < SM_FFNCONV) v = p.subln_in[idx - SM_SUBLN];
        else if (idx < SM_FINALG) v = p.ffn_conv_in[idx - SM_FFNCONV];
        else v = p.final_g_in[idx - SM_FINALG];
        ((float*)p.g1)[idx] = v;
      }
      continue;
    }
    it -= nS;
    {
      for (int e = tid; e < 2048; e += NTHREADS) ((unsigned*)p.zero)[e] = 0u;
      if (tid < 2) {
        const int l = tid;
        float s1 = 0.f, s2 = 0.f;
        for (int i = 0; i < 32; ++i) { s1 += p.lq1[l * 32 + i] * p.lk1[l * 32 + i]; s2 += p.lq2[l * 32 + i] * p.lk2[l * 32 + i]; }
        const float lam_init = 0.8f - 0.6f * expf(-0.3f * (float)l);
        p.lam[l] = expf(s1) - expf(s2) + lam_init;
        p.lam[2 + l] = lam_init;
      }
    }
  }
}

__device__ __forceinline__ float wave_sum(float v) {
#pragma unroll
  for (int o = 32; o >= 1; o >>= 1) v += __shfl_xor(v, o);
  return v;
}

__device__ void norm_phase(const Params& p, int l, int which  , bool from_input, int nrows) {
  const int tid_ = opaque_tid(); const int lane = tid_ & 63, wid = tid_ >> 6;
  const float* gv = (which == 0 ? p.g1 : p.g2) + l * 1024;
  const int sh_off = which == 0 ? 0 : 3072, sc_off = which == 0 ? 1024 : 4096;
  for (int row = blockIdx.x * NWAVES + wid; row < nrows; row += gridDim.x * NWAVES) {
    const float* xr;
    if (row < NLAT) xr = (from_input ? p.x : p.out) + (size_t)row * 1024;
    else xr = (from_input ? p.ctx : p.Xc) + (size_t)(row - NLAT) * 1024;
    f32x4 v[4];
    float ss = 0.f;
#pragma unroll
    for (int i = 0; i < 4; ++i) {
      v[i] = *(const f32x4*)(xr + i * 256 + lane * 4);
      ss += v[i][0] * v[i][0] + v[i][1] * v[i][1] + v[i][2] * v[i][2] + v[i][3] * v[i][3];
    }
    ss = wave_sum(ss);
    const float rstd = rsqrtf(ss * (1.f / 1024.f) + EPS);
    const int mi = row < NLAT ? (row >> 11) : 16;
    const float* md = p.mod + (size_t)(l * 17 + mi) * 6144;
#pragma unroll
    for (int i = 0; i < 4; ++i) {
      const int k = i * 256 + lane * 4;
      const f32x4 g = *(const f32x4*)(gv + k), sc = *(const f32x4*)(md + sc_off + k), sh = *(const f32x4*)(md + sh_off + k);
      float y[4];
#pragma unroll
      for (int e = 0; e < 4; ++e) y[e] = v[i][e] * rstd * g[e] * (1.f + sc[e]) + sh[e];
      *(h16x4*)(p.H16 + (size_t)row * 1024 + k) = pack4(y[0], y[1], y[2], y[3]);
    }
  }
}

__device__ void final_norm_phase(const Params& p) {
  const int tid_ = opaque_tid(); const int lane = tid_ & 63, wid = tid_ >> 6;
  for (int row = blockIdx.x * NWAVES + wid; row < NLAT; row += gridDim.x * NWAVES) {
    float* xr = p.out + (size_t)row * 1024;
    f32x4 v[4];
    float ss = 0.f;
#pragma unroll
    for (int i = 0; i < 4; ++i) {
      v[i] = *(const f32x4*)(xr + i * 256 + lane * 4);
      ss += v[i][0] * v[i][0] + v[i][1] * v[i][1] + v[i][2] * v[i][2] + v[i][3] * v[i][3];
    }
    ss = wave_sum(ss);
    const float rstd = rsqrtf(ss * (1.f / 1024.f) + EPS);
#pragma unroll
    for (int i = 0; i < 4; ++i) {
      const int k = i * 256 + lane * 4;
      const f32x4 g = *(const f32x4*)(p.final_g + k);
      f32x4 y;
#pragma unroll
      for (int e = 0; e < 4; ++e) y[e] = v[i][e] * rstd * g[e];
      *(f32x4*)(xr + k) = y;
    }
  }
}

__device__ __forceinline__ void rope16(f32x4& a, const float* tab, const int g4, const bool on) {
  f32x4 pr;
#pragma unroll
  for (int e = 0; e < 4; ++e) pr[e] = __shfl_xor(a[e], 32);
  if (on) {
    const f32x4 c = *(const f32x4*)(tab), s = *(const f32x4*)(tab + 8);
#pragma unroll
    for (int e = 0; e < 4; ++e) a[e] = (g4 < 2) ? (a[e] * c[e] - pr[e] * s[e]) : (a[e] * c[e] + pr[e] * s[e]);
  }
}

__device__ __forceinline__ int vblock() { return (blockIdx.x & 7) * (gridDim.x >> 3) + (blockIdx.x >> 3); }
__device__ __forceinline__ void tile_map(int it, int nMt, int nNt, int PM, int& mt, int& nt) {
  const int per = PM * nNt;
  const int panel = it / per, rem = it - panel * per, m0 = panel * PM;
  const int pmw = (nMt - m0) < PM ? (nMt - m0) : PM;
  nt = rem / pmw; mt = m0 + rem % pmw;
}
#define TID_DECL const int tid = opaque_tid(), lane = tid & 63, wid = tid >> 6, wm = wid >> 2, wn = wid & 3, l15 = lane & 15, g4 = lane >> 4;

__device__ void p1_phase(const Params& p, int l, unsigned char* smem) {
  const h16* WT = p.WinT + (size_t)l * ZC * 1024;
  const int nmain = (l == 0) ? 144 * 10 : 128 * 10, nextra = (l == 0) ? 0 : 32;
  for (int t = vblock(); t < nmain + nextra; t += gridDim.x) {
    TID_DECL
    int tm, tn;
    if (t < nmain) tile_map(t, (l == 0) ? 144 : 128, 10, 16, tm, tn);
    else { const int u = t - nmain; tm = 128 + (u & 15); tn = 8 + (u >> 4); }
    f32x4 acc[8][4];
    const h16* Abase = p.H16 + (size_t)tm * 256 * 1024;
    gemm256(acc, [&](int i) { return Abase + (size_t)i * 1024; }, WT + (size_t)tn * 256 * 1024, 1024, 1024, smem, tid);
    const int g = tn;
    const int cgw = wn * 64 + 4 * g4;
#pragma unroll
    for (int mi = 0; mi < 8; ++mi) {
      const int R = tm * 256 + wm * 128 + mi * 16 + l15;
      const bool isctx = R >= NLAT;
      int b, pos;
      if (!isctx) { b = R >> 11; pos = R & 2047; } else { const int rc = R - NLAT; b = rc >> 8; pos = rc & 255; }
      if (g == 0) {
#pragma unroll
        for (int nj = 0; nj < 4; ++nj) {
          const f32x4& a = acc[mi][nj];
          *(h16x4*)(p.U16 + (size_t)R * 256 + cgw + nj * 16) = pack4(gelu_f(a[0]), gelu_f(a[1]), gelu_f(a[2]), gelu_f(a[3]));
        }
      } else if (g == 1) {
        float ss = 0.f;
#pragma unroll
        for (int nj = 0; nj < 4; ++nj)
#pragma unroll
          for (int e = 0; e < 4; ++e) { const float v = gelu_f(acc[mi][nj][e]); acc[mi][nj][e] = v; ss += v * v; }
        ss += __shfl_xor(ss, 16);
        ss += __shfl_xor(ss, 32);
        const float rinv = rsqrtf(ss * (1.f / 64.f) + EPS);
        const int head = wn;
        h16* base; int stride;
        if (!isctx) { base = p.VTl + ((size_t)(head * 1024 + b * 64) * 2048 + pos); stride = 2048; }
        else { base = p.VTc + ((size_t)(head * 1024 + b * 64) * 256 + pos); stride = 256; }
#pragma unroll
        for (int nj = 0; nj < 4; ++nj)
#pragma unroll
          for (int e = 0; e < 4; ++e) {
            const int d = nj * 16 + 4 * g4 + e;
            base[(size_t)d * stride] = (h16)(acc[mi][nj][e] * rinv);
          }
      } else if (g <= 4) {
#pragma unroll
        for (int nj = 0; nj < 4; ++nj) {
          const f32x4& a = acc[mi][nj];
          *(h16x4*)(p.ZB + (size_t)R * 768 + (g - 2) * 256 + cgw + nj * 16) = pack4(a[0], a[1], a[2], a[3]);
        }
      } else if (g <= 6) {
        h16* base; int stride;
        if (!isctx) { base = p.GTl + ((size_t)(b * 256 + cgw) * 4096 + (g == 6 ? 2048 : 0) + pos); stride = 4096; }
        else { base = p.GTc + ((size_t)(b * 256 + cgw) * 512 + (g == 6 ? 256 : 0) + pos); stride = 512; }
#pragma unroll
        for (int nj = 0; nj < 4; ++nj)
#pragma unroll
          for (int e = 0; e < 4; ++e) base[(size_t)(nj * 16 + e) * stride] = (h16)acc[mi][nj][e];
      } else if (g == 7) {
        const float qs = 0.17677669529663687f * 1.4426950408889634f;
#pragma unroll
        for (int nj = 0; nj < 4; ++nj) {
          rope16(acc[mi][nj], p.rope + (size_t)pos * 32 + (nj & 1) * 16 + 4 * (g4 & 1), g4, !isctx);
          const f32x4& a = acc[mi][nj];
          *(h16x4*)(p.Q16 + (size_t)R * 256 + cgw + nj * 16) = pack4(a[0] * qs, a[1] * qs, a[2] * qs, a[3] * qs);
        }
      } else if (g == 8) {
        const int key = isctx ? pos : 256 + pos;
#pragma unroll
        for (int nj = 0; nj < 4; ++nj) {
          rope16(acc[mi][nj], p.rope + (size_t)pos * 32 + (nj & 1) * 16 + 4 * (g4 & 1), g4, !isctx);
          const f32x4& a = acc[mi][nj];
          *(h16x4*)(p.K16 + ((size_t)b * NKEY + key) * 256 + cgw + nj * 16) = pack4(a[0], a[1], a[2], a[3]);
        }
      } else {
        const int key = isctx ? pos : 256 + pos;
        h16* base = p.VT16 + ((size_t)(b * 256 + cgw) * NKEY + key);
#pragma unroll
        for (int nj = 0; nj < 4; ++nj)
#pragma unroll
          for (int e = 0; e < 4; ++e) base[(size_t)(nj * 16 + e) * NKEY] = (h16)acc[mi][nj][e];
      }
    }
  }
}

__device__ void attn_unit(const Params& p, int l, int b, int h, int qrow0, int nkeys, unsigned char* smem, const int tid) {
  const int lane = tid & 63, w = tid >> 6, l31 = lane & 31, hf = lane >> 5;
  const h16* Kbase = p.K16 + (size_t)b * NKEY * 256 + h * 64;
  const h16* Vbase = p.VT16 + (size_t)(b * 256 + h * 64) * NKEY;
  const int qrow = qrow0 + w * 32 + l31;
  h16x8 qf0[2][2];
#pragma unroll
  for (int m = 0; m < 2; ++m)
#pragma unroll
    for (int s = 0; s < 2; ++s) qf0[m][s] = *(const h16x8*)(p.Q16 + (size_t)qrow * 256 + h * 64 + m * 32 + s * 16 + hf * 8);
  unsigned char* Qs = smem + 49152 + tid * 16;
  f32x16 O[2][2];
#pragma unroll
  for (int m = 0; m < 2; ++m)
#pragma unroll
    for (int dt = 0; dt < 2; ++dt)
#pragma unroll
      for (int r = 0; r < 16; ++r) O[m][dt][r] = 0.f;
  float mrun[2] = {0.f, 0.f}, lsum[2] = {0.f, 0.f};
  const int sr = tid >> 3, sc = tid & 7;
  const int gc = (sc ^ ((sr >> 1) & 7)) * 8;
  const h16* kp = Kbase + (size_t)sr * 256 + gc;
  const h16* vp = Vbase + (size_t)sr * NKEY + gc;
  LAS unsigned char* lds = (LAS unsigned char*)smem;
  const int wbase = __builtin_amdgcn_readfirstlane(w) * 1024;
  const int nt = nkeys >> 6;
#define ATT_ISSUE(kt, st) do {                                                                                           \
    __builtin_amdgcn_global_load_lds((const unsigned*)(kp + (size_t)(kt) * 64 * 256), (LAS unsigned*)(lds + (st) * 16384 + wbase), 16, 0, 0); \
    __builtin_amdgcn_global_load_lds((const unsigned*)(vp + (kt) * 64), (LAS unsigned*)(lds + (st) * 16384 + 8192 + wbase), 16, 0, 0); } while (0)
  const int ksw = (l31 >> 1) & 7;
#define ATT_QK(S, Ks_, m_, sub_) do {                                                                                    \
    const float nm_ = -mrun[m_];                                                                                         \
    _Pragma("unroll") for (int r = 0; r < 16; ++r) S[r] = nm_;                                                           \
    _Pragma("unroll") for (int s = 0; s < 2; ++s) {                                                                      \
      const int ch = (((m_) * 4 + s * 2 + hf) ^ ksw) << 4;                                                               \
      const h16x8 kf = *(const h16x8*)((Ks_) + ((sub_) * 32 + l31) * 128 + ch);                                          \
      const h16x8 qv = *(const h16x8*)(Qs + ((m_) * 2 + s) * 8192);                                                      \
      S = __builtin_amdgcn_mfma_f32_32x32x16_f16(kf, qv, S, 0, 0, 0); } } while (0)
  __syncthreads();
#pragma unroll
  for (int m = 0; m < 2; ++m)
#pragma unroll
    for (int s = 0; s < 2; ++s) *(h16x8*)(Qs + (m * 2 + s) * 8192) = qf0[m][s];
  ATT_ISSUE(0, 0);
  if (nt > 1) ATT_ISSUE(1, 1);
  asm volatile("s_waitcnt vmcnt(0)" ::: "memory");
  __syncthreads();
  f32x16 scur[2];
  ATT_QK(scur[0], smem, 0, 0);
  ATT_QK(scur[1], smem, 1, 0);
  int st = 0;
  for (int kt = 0; kt < nt; ++kt) {
    const int st1 = (st == 2) ? 0 : st + 1, st2 = (st1 == 2) ? 0 : st1 + 1;
    if (kt + 2 < nt) ATT_ISSUE(kt + 2, st2);
    const unsigned char* Kc = smem + st * 16384;
    const unsigned char* Vs = Kc + 8192;
    const unsigned char* Kn = smem + st1 * 16384;
#pragma unroll
    for (int sub = 0; sub < 2; ++sub) {
      const bool more = (sub == 0) || (kt + 1 < nt);
      const bool first = (kt == 0) && (sub == 0);
#pragma unroll
      for (int m = 0; m < 2; ++m) {
        f32x16 sn;
        if (more) { if (sub == 0) ATT_QK(sn, Kc, m, 1); else ATT_QK(sn, Kn, m, 0); }
        f32x16& s0 = scur[m];
        h16x8 pf[2];
        {
          float mx = s0[0];
#pragma unroll
          for (int r = 1; r < 16; ++r) mx = fmaxf(mx, s0[r]);
          mx = fmaxf(mx, __shfl_xor(mx, 32));
          if (__any(first || (mx > 8.f))) {
            const float delta = first ? mx : fmaxf(mx, 0.f);
            const float alpha = first ? 1.f : __builtin_amdgcn_exp2f(-delta);
            mrun[m] += delta;
            lsum[m] *= alpha;
#pragma unroll
            for (int r = 0; r < 16; ++r) s0[r] -= delta;
            if (more) {
#pragma unroll
              for (int r = 0; r < 16; ++r) sn[r] -= delta;
            }
#pragma unroll
            for (int dt = 0; dt < 2; ++dt)
#pragma unroll
              for (int r = 0; r < 16; ++r) O[m][dt][r] *= alpha;
          }
          float ps = 0.f;
#pragma unroll
          for (int r = 0; r < 16; ++r) { s0[r] = __builtin_amdgcn_exp2f(s0[r]); ps += s0[r]; }
          lsum[m] += ps;
#pragma unroll
          for (int sp = 0; sp < 2; ++sp) {
            u32x4 w0;
#pragma unroll
            for (int j = 0; j < 4; ++j)
              w0[j] = __builtin_bit_cast(unsigned, __builtin_amdgcn_cvt_pkrtz(s0[8 * sp + 2 * j], s0[8 * sp + 2 * j + 1]));
            pf[sp] = __builtin_bit_cast(h16x8, w0);
          }
        }
#pragma unroll
        for (int dt = 0; dt < 2; ++dt)
#pragma unroll
          for (int sp = 0; sp < 2; ++sp) {
            const int gA = sub * 8 + 4 * sp + hf, gB = gA + 2;
            const int vrow = (dt * 32 + l31) * 128;
            const h16x4 lo = *(const h16x4*)(Vs + vrow + ((((gA >> 1) ^ ksw) << 4) | ((gA & 1) << 3)));
            const h16x4 hi = *(const h16x4*)(Vs + vrow + ((((gB >> 1) ^ ksw) << 4) | ((gB & 1) << 3)));
            h16x8 vf;
            vf[0] = lo[0]; vf[1] = lo[1]; vf[2] = lo[2]; vf[3] = lo[3]; vf[4] = hi[0]; vf[5] = hi[1]; vf[6] = hi[2]; vf[7] = hi[3];
            O[m][dt] = __builtin_amdgcn_mfma_f32_32x32x16_f16(vf, pf[sp], O[m][dt], 0, 0, 0);
          }
        if (more) s0 = sn;
      }
    }
    asm volatile("s_waitcnt vmcnt(0)" ::: "memory");
    __syncthreads();
    st = st1;
  }
#undef ATT_ISSUE
#undef ATT_QK
  const float lam = ldvol(p.lam + l), lam_init = ldvol(p.lam + 2 + l);
  float l0 = lsum[0] + __shfl_xor(lsum[0], 32), l1 = lsum[1] + __shfl_xor(lsum[1], 32);
  const float i0 = 1.f / l0, i1 = lam / l1;
  float ss = 0.f;
#pragma unroll
  for (int dt = 0; dt < 2; ++dt)
#pragma unroll
    for (int r = 0; r < 16; ++r) { const float o = O[0][dt][r] * i0 - O[1][dt][r] * i1; O[0][dt][r] = o; ss += o * o; }
  ss += __shfl_xor(ss, 32);
  const float rinv = rsqrtf(ss * (1.f / 64.f) + EPS) * (1.f - lam_init);
  h16* orow = p.H16 + (size_t)qrow * 1024 + 768 + h * 64;
#pragma unroll
  for (int dt = 0; dt < 2; ++dt)
#pragma unroll
    for (int q = 0; q < 4; ++q) {
      const int d = dt * 32 + q * 8 + hf * 4;
      const f32x4 g = *(const f32x4*)(p.subln + l * 64 + d);
      *(h16x4*)(orow + d) = pack4(O[0][dt][4 * q] * rinv * g[0], O[0][dt][4 * q + 1] * rinv * g[1],
                                  O[0][dt][4 * q + 2] * rinv * g[2], O[0][dt][4 * q + 3] * rinv * g[3]);
    }
}

__device__ void p2_phase(const Params& p, int l, unsigned char* smem, unsigned* queue) {
  const bool ctxon = (l == 0);
  const int nDl = 80, nAl = 512, nAc = ctxon ? 64 : 0, nDc = ctxon ? 16 : 0, nGl = 256, nGc = ctxon ? 32 : 0;
  const int nBrows = ctxon ? NTOK : NLAT, nB = nBrows / 16;
  const int total = nDl + nAl + nAc + nDc + nGl + nGc + nB;
  h16* MIX = p.H16;
  int* qslot = (int*)(smem + LDS_BYTES - 16);
  for (;;) {
    TID_DECL
    __syncthreads();
    if (tid == 0) *qslot = (int)__hip_atomic_fetch_add(queue, 1u, __ATOMIC_RELAXED, __HIP_MEMORY_SCOPE_AGENT);
    __syncthreads();
    int it = *qslot;
    if (it >= total) break;
    if (it < nDl) {
      const int tm = it >> 4, tn = it & 15;
      f32x4 acc[8][4];
      const h16* Ab = p.Fn + (size_t)tm * 256 * 4096;
      gemm256(acc, [&](int i) { return Ab + (size_t)i * 4096; }, p.GTl + (size_t)tn * 256 * 4096, 4096, 4096, smem, tid);
      const int b = tn, c0 = wn * 64 + 4 * g4;
#pragma unroll
      for (int mi = 0; mi < 8; ++mi) {
        const int k1 = tm * 256 + wm * 128 + mi * 16 + l15;
        h16* o = MIX + ((size_t)b * 2048 + k1) * 1024 + 512 + c0;
#pragma unroll
        for (int nj = 0; nj < 4; ++nj) {
          const f32x4& a = acc[mi][nj];
          *(h16x4*)(o + nj * 16) = pack4(a[0], a[1], a[2], a[3]);
        }
        if (k1 >= 1 && k1 <= 768) {
          h16* om = MIX + ((size_t)b * 2048 + (2048 - k1)) * 1024 + 512 + wn * 64;
#pragma unroll
          for (int nj = 0; nj < 4; ++nj)
#pragma unroll
            for (int e = 0; e < 4; ++e) om[(64 - (nj * 16 + 4 * g4 + e)) & 63] = (h16)acc[mi][nj][e];
        }
      }
      continue;
    }
    it -= nDl;
    if (it < nAl) {
      const int qb = it & 7, h = (it >> 3) & 3, b = it >> 5;
      attn_unit(p, l, b, h, b * 2048 + qb * 256, NKEY, smem, tid);
      continue;
    }
    it -= nAl;
    if (it < nAc) {
      const int h = it & 3, b = it >> 2;
      attn_unit(p, l, b, h, NLAT + b * 256, 256, smem, tid);
      continue;
    }
    it -= nAc;
    if (it < nDc) {
      const int tn = it;
      f32x4 acc[8][4];
      gemm256(acc, [&](int i) { return p.Fc + (size_t)i * 512; }, p.GTc + (size_t)tn * 256 * 512, 512, 512, smem, tid);
      const int b = tn, c0 = wn * 64 + 4 * g4;
#pragma unroll
      for (int mi = 0; mi < 8; ++mi) {
        const int k1 = wm * 128 + mi * 16 + l15;
        h16* o = MIX + ((size_t)NLAT + b * 256 + k1) * 1024 + 512 + c0;
#pragma unroll
        for (int nj = 0; nj < 4; ++nj) {
          const f32x4& a = acc[mi][nj];
          *(h16x4*)(o + nj * 16) = pack4(a[0], a[1], a[2], a[3]);
        }
      }
      continue;
    }
    it -= nDc;
    if (it < nGl + nGc) {
      const bool isc = it >= nGl;
      int h, c, tn;
      if (!isc) { tn = it & 3; c = (it >> 2) & 15; h = it >> 6; }
      else { const int u = it - nGl; tn = u & 3; c = (u >> 2) & 1; h = u >> 3; }
      const int ldb = isc ? 256 : 2048;
      const h16* Bt = (isc ? p.VTc : p.VTl) + (size_t)(h * 1024 + tn * 256) * ldb + c * 128;
      const h16* Ab = p.Ws16 + (size_t)(l * 4 + h) * 128 * 128;
      f32x4 acc[8][4];
      gemm256(acc, [&](int i) { return i < 128 ? Ab + (size_t)i * 128 : p.zero; }, Bt, ldb, 128, smem, tid);
      if (wm == 0) {
#pragma unroll
        for (int mi = 0; mi < 8; ++mi) {
          const int pp = mi * 16 + l15;
          const float bias = p.gm_bs[(l * 4 + h) * 128 + pp];
#pragma unroll
          for (int nj = 0; nj < 4; ++nj) {
            const int ng = tn * 256 + wn * 64 + nj * 16;
            const int b = ng >> 6, d = (ng & 63) + 4 * g4;
            const size_t R = isc ? ((size_t)NLAT + b * 256 + c * 128 + pp) : ((size_t)b * 2048 + c * 128 + pp);
            const h16x4 u = *(const h16x4*)(p.U16 + R * 256 + h * 64 + d);
            const f32x4& a = acc[mi][nj];
            *(h16x4*)(MIX + R * 1024 + h * 64 + d) =
                pack4((a[0] + bias) * (float)u[0], (a[1] + bias) * (float)u[1], (a[2] + bias) * (float)u[2], (a[3] + bias) * (float)u[3]);
          }
        }
      }
      continue;
    }
    it -= nGl + nGc;
    {
      const int R = it * 16 + (tid >> 5);
      const int j0 = (tid & 31) * 8;
      int pos, len;
      if (R < NLAT) { pos = R & 2047; len = 2048; } else { pos = (R - NLAT) & 255; len = 256; }
      const h16* zr = p.ZB + (size_t)R * 768;
      float P[3][8];
#pragma unroll
      for (int dlt = 0; dlt < 3; ++dlt) {
        const int pp = pos + dlt - 1;
        if (pp >= 0 && pp < len) {
          const h16x8 bx = *(const h16x8*)(zr + (dlt - 1) * 768 + j0);
          const h16x8 bc = *(const h16x8*)(zr + (dlt - 1) * 768 + 512 + j0);
#pragma unroll
          for (int e = 0; e < 8; ++e) P[dlt][e] = (float)bx[e] * (float)bc[e];
        } else {
#pragma unroll
          for (int e = 0; e < 8; ++e) P[dlt][e] = 0.f;
        }
      }
      const h16x8 bb = *(const h16x8*)(zr + 256 + j0);
      const float* w = p.sc_w + l * 768 + j0;
      h16x8 o;
#pragma unroll
      for (int e = 0; e < 8; ++e)
        o[e] = (h16)((float)bb[e] * (w[e] * P[0][e] + w[256 + e] * P[1][e] + w[512 + e] * P[2][e]));
      *(h16x8*)(MIX + (size_t)R * 1024 + 256 + j0) = o;
    }
  }
}

__device__ void resid_gemm_phase(const Params& p, int l, int which  , bool from_input, int nrows,
                                 unsigned char* smem) {
  const int ntiles = (nrows / 256) * 4;
  const h16* A = which == 0 ? p.H16 : p.ACT;
  const int K = which == 0 ? 1024 : DFF;
  const h16* WT = which == 0 ? p.WoutT + (size_t)l * 1024 * 1024 : p.WdownT + (size_t)l * 1024 * DFF;
  const int goff = which == 0 ? 2048 : 5120;
  for (int t = vblock(); t < ntiles; t += gridDim.x) {
    TID_DECL
    int tm, tn;
    tile_map(t, nrows / 256, 4, 8, tm, tn);
    f32x4 acc[8][4];
    const h16* Ab = A + (size_t)tm * 256 * K;
    gemm256(acc, [&](int i) { return Ab + (size_t)i * K; }, WT + (size_t)tn * 256 * K, K, K, smem, tid);
#pragma unroll
    for (int mi = 0; mi < 8; ++mi) {
      const int R = tm * 256 + wm * 128 + mi * 16 + l15;
      const float* xin; float* xo; int mod_i;
      if (R < NLAT) { xin = (from_input ? p.x : p.out) + (size_t)R * 1024; xo = p.out + (size_t)R * 1024; mod_i = R >> 11; }
      else { xin = (from_input ? p.ctx : p.Xc) + (size_t)(R - NLAT) * 1024; xo = p.Xc + (size_t)(R - NLAT) * 1024; mod_i = 16; }
      const float* gt = p.mod + (size_t)(l * 17 + mod_i) * 6144 + goff;
#pragma unroll
      for (int nj = 0; nj < 4; ++nj) {
        const int n = tn * 256 + wn * 64 + nj * 16 + 4 * g4;
        const f32x4 xi = *(const f32x4*)(xin + n), gg = *(const f32x4*)(gt + n);
        const f32x4& a = acc[mi][nj];
        f32x4 y;
#pragma unroll
        for (int e = 0; e < 4; ++e) y[e] = xi[e] + gg[e] * a[e];
        *(f32x4*)(xo + n) = y;
      }
    }
  }
}

__device__ void p4_phase(const Params& p, int l, int nrows, unsigned char* smem) {
  const int nmt = (nrows + 253) / 254;
  const int ntiles = nmt * 22;
  const h16* WT = p.WupT + (size_t)l * 5632 * 1024;
  const float* cw = p.ffn_conv + (size_t)l * 3 * DFF;
  h16* abuf = (h16*)smem;
  for (int it = vblock(); it < ntiles; it += gridDim.x) {
    TID_DECL
    int nt, t;
    tile_map(it, nmt, 22, 16, t, nt);
    const int R0 = 254 * t - 1;
    f32x4 acc[8][4];
    gemm256(acc, [&](int i) -> const h16* { const int R = R0 + i; return (R >= 0 && R < nrows) ? p.H16 + (size_t)R * 1024 : p.zero; },
            WT + (size_t)nt * 256 * 1024, 1024, 1024, smem, tid);
#pragma unroll
    for (int mi = 0; mi < 8; ++mi) {
      const int m = wm * 128 + mi * 16 + l15;
#pragma unroll
      for (int pj = 0; pj < 2; ++pj)
        *(h16x4*)(abuf + m * 136 + wn * 32 + pj * 16 + 4 * g4) =
            pack4(acc[mi][2 * pj][0], acc[mi][2 * pj][1], acc[mi][2 * pj][2], acc[mi][2 * pj][3]);
    }
    __syncthreads();
#pragma unroll
    for (int mi = 0; mi < 8; ++mi) {
      const int m = wm * 128 + mi * 16 + l15;
      const int R = R0 + m;
      if (m >= 1 && m <= 254 && R < nrows) {
        int ps, len;
        if (R < NLAT) { ps = R & 2047; len = 2048; } else { ps = (R - NLAT) & 255; len = 256; }
        const float mp = (ps == 0) ? 0.f : 1.f, mn = (ps == len - 1) ? 0.f : 1.f;
#pragma unroll
        for (int pj = 0; pj < 2; ++pj) {
          const int ja = wn * 32 + pj * 16 + 4 * g4;
          const int j = nt * 128 + ja;
          const h16x4 ap = *(const h16x4*)(abuf + (m - 1) * 136 + ja), an = *(const h16x4*)(abuf + (m + 1) * 136 + ja);
          const f32x4 w0 = *(const f32x4*)(cw + j), w1 = *(const f32x4*)(cw + DFF + j), w2 = *(const f32x4*)(cw + 2 * DFF + j);
          float y[4];
#pragma unroll
          for (int e = 0; e < 4; ++e) {
            const float cv = w0[e] * mp * (float)ap[e] + w1[e] * acc[mi][2 * pj][e] + w2[e] * mn * (float)an[e];
            y[e] = silu_f(cv) * acc[mi][2 * pj + 1][e];
          }
          *(h16x4*)(p.ACT + (size_t)R * DFF + j) = pack4(y[0], y[1], y[2], y[3]);
        }
      }
    }
  }
}

__device__ __forceinline__ void grid_bar(unsigned* ctr, unsigned target) {
  asm volatile("s_waitcnt vmcnt(0) lgkmcnt(0)" ::: "memory");
  __syncthreads();
  if (threadIdx.x == 0) {
    __builtin_amdgcn_fence(__ATOMIC_RELEASE, "agent");
    asm volatile("s_waitcnt vmcnt(0)" ::: "memory");
    __hip_atomic_fetch_add(ctr, 1u, __ATOMIC_RELAXED, __HIP_MEMORY_SCOPE_AGENT);
    while (__hip_atomic_load(ctr, __ATOMIC_RELAXED, __HIP_MEMORY_SCOPE_AGENT) < target) __builtin_amdgcn_s_sleep(2);
    __builtin_amdgcn_fence(__ATOMIC_ACQUIRE, "agent");
    asm volatile("s_waitcnt vmcnt(0)" ::: "memory");
  }
  __syncthreads();
}

__global__ void __launch_bounds__(NTHREADS, 2) mega_kernel(KArgs ka) {
  __shared__ __attribute__((aligned(1024))) unsigned char smem[LDS_BYTES];
  cg::grid_group grid = cg::this_grid();
  const Params p = make_params(ka);
  if (blockIdx.x == 0 && threadIdx.x < 8) __hip_atomic_store(p.bar + threadIdx.x * 16, 0u, __ATOMIC_RELAXED, __HIP_MEMORY_SCOPE_AGENT);
  unsigned nbar = 0;
  const unsigned G = gridDim.x;
#define GBAR() do { ++nbar; grid_bar(p.bar, nbar * G); } while (0)
  prep_phase(p, smem, p.bar + 16 * 5);
  grid.sync();
  norm_phase(p, 0, 0, true, NTOK);
  GBAR();
  for (int l = 0; l < 2; ++l) {
    const bool first = (l == 0);
    const int nrows = first ? NTOK : NLAT;
    p1_phase(p, l, smem);
    GBAR();
    p2_phase(p, l, smem, p.bar + 16 * (1 + l));
    GBAR();
    resid_gemm_phase(p, l, 0, first, nrows, smem);
    GBAR();
    norm_phase(p, l, 1, false, nrows);
    GBAR();
    p4_phase(p, l, nrows, smem);
    GBAR();
    resid_gemm_phase(p, l, 1, false, nrows, smem);
    GBAR();
    if (first) { norm_phase(p, 1, 0, false, NTOK); GBAR(); }
  }
  final_norm_phase(p);
}

extern "C" void kernel_launch(void* const* d_in, const int* in_sizes, int n_in, void* d_out, int out_size, void* d_ws,
                              size_t ws_size, hipStream_t stream) {
  static int grid_blocks = 0;
  if (!grid_blocks) {
    int dev = 0, cus = 0, per_cu = 0;
    (void)hipGetDevice(&dev);
    (void)hipDeviceGetAttribute(&cus, hipDeviceAttributeMultiprocessorCount, dev);
    (void)hipOccupancyMaxActiveBlocksPerMultiprocessor(&per_cu, mega_kernel, NTHREADS, 0);
    if (per_cu > 1) per_cu = 1;
    if (per_cu < 1) per_cu = 1;
    grid_blocks = cus * per_cu;
  }
  KArgs a{};
  for (int i = 0; i < 22; ++i) a.in[i] = (const float*)d_in[i];
  a.out = (float*)d_out;
  a.ws = (unsigned char*)d_ws;
  if (OFF_END > ws_size) fprintf(stderr, "workspace too small: need %zu have %zu\n", (size_t)OFF_END, ws_size);
  void* args[] = {&a};
  hipError_t e = hipLaunchCooperativeKernel((void*)mega_kernel, dim3(grid_blocks), dim3(NTHREADS), args, 0, stream);
  if (e != hipSuccess) fprintf(stderr, "cooperative launch failed: %s (grid %d)\n", hipGetErrorString(e), grid_blocks);
}
```

```cpp
#include <hip/hip_runtime.h>
#include <hip/hip_cooperative_groups.h>
#include <cstdio>
#include <cstdint>
namespace cg = cooperative_groups;

typedef _Float16 h16;
typedef h16 h16x8 __attribute__((ext_vector_type(8)));
typedef h16 h16x4 __attribute__((ext_vector_type(4)));
typedef float f32x16 __attribute__((ext_vector_type(16)));
typedef float f32x4 __attribute__((ext_vector_type(4)));
typedef unsigned u32x4 __attribute__((ext_vector_type(4)));

#define DM 1024
#define NBATCH 16
#define SEQ 2048
#define LCTX 256
#define NLAT 32768
#define NCTX 4096
#define NTOK 36864
#define ZC 2560
#define DFF 2816
#define NKEY 2304
#define EPS 1e-6f
#define NTHREADS 512
#define NWAVES 8
#define LDS_BYTES 131072
#define LDS_STAGE 65536

struct Params {
  const float *x, *c, *ctx, *c_ctx, *w_ada, *b_ada, *w_in, *gm_ws;
  const float *lq1, *lk1, *lq2, *lk2, *w_out, *w_up, *w_down;
  const float *g1_in, *g2_in, *gm_bs_in, *sc_w_in, *subln_in, *ffn_conv_in, *final_g_in;
  const float *g1, *g2, *gm_bs, *sc_w, *subln, *ffn_conv, *final_g;
  float* out;
  float* mod; float* lam; float* rope; float* Xc; const h16* zero; unsigned* bar;
  h16 *WinT, *WoutT, *WupT, *WdownT, *Ws16, *Fn, *Fc;
  h16 *H16;
  h16 *U16, *VTl, *VTc, *ZB, *GTl, *GTc, *Q16, *K16, *VT16, *ACT;
};
struct KArgs { const float* in[22]; float* out; unsigned char* ws; };

constexpr size_t al256(size_t x) { return (x + 255) & ~(size_t)255; }
constexpr size_t OFF_MOD = 0;
constexpr size_t OFF_LAM = OFF_MOD + al256((size_t)2 * 17 * 6144 * 4);
constexpr size_t OFF_ROPE = OFF_LAM + 256;
constexpr size_t OFF_SMALL = OFF_ROPE + al256((size_t)2048 * 32 * 4);
constexpr size_t OFF_ZERO = OFF_SMALL + al256((size_t)32768 * 4);
constexpr size_t OFF_BAR = OFF_ZERO + 8192;
constexpr size_t OFF_XC = OFF_BAR + 1024;
constexpr size_t OFF_WINT = OFF_XC + al256((size_t)NCTX * 1024 * 4);
constexpr size_t OFF_WOUTT = OFF_WINT + al256((size_t)2 * ZC * 1024 * 2);
constexpr size_t OFF_WUPT = OFF_WOUTT + al256((size_t)2 * 1024 * 1024 * 2);
constexpr size_t OFF_WDOWNT = OFF_WUPT + al256((size_t)2 * 5632 * 1024 * 2);
constexpr size_t OFF_WS16 = OFF_WDOWNT + al256((size_t)2 * 1024 * DFF * 2);
constexpr size_t OFF_FN = OFF_WS16 + al256((size_t)2 * 4 * 128 * 128 * 2);
constexpr size_t OFF_FC = OFF_FN + al256((size_t)2048 * 4096 * 2);
constexpr size_t OFF_H16 = OFF_FC + al256((size_t)256 * 512 * 2);
constexpr size_t OFF_ACT = OFF_H16 + al256((size_t)NTOK * 1024 * 2);
constexpr size_t OFF_END = OFF_ACT + al256((size_t)NTOK * DFF * 2);
constexpr size_t OFF_U16 = OFF_ACT;
constexpr size_t OFF_VTL = OFF_U16 + al256((size_t)NTOK * 256 * 2);
constexpr size_t OFF_VTC = OFF_VTL + al256((size_t)4 * 1024 * 2048 * 2);
constexpr size_t OFF_ZB = OFF_VTC + al256((size_t)4 * 1024 * 256 * 2);
constexpr size_t OFF_GTL = OFF_ZB + al256((size_t)NTOK * 768 * 2);
constexpr size_t OFF_GTC = OFF_GTL + al256((size_t)4096 * 4096 * 2);
constexpr size_t OFF_Q16 = OFF_GTC + al256((size_t)4096 * 512 * 2);
constexpr size_t OFF_K16 = OFF_Q16 + al256((size_t)NTOK * 256 * 2);
constexpr size_t OFF_VT16 = OFF_K16 + al256((size_t)NBATCH * NKEY * 256 * 2);
constexpr size_t OFF_REGION_END = OFF_VT16 + al256((size_t)NBATCH * 256 * NKEY * 2);
static_assert(OFF_REGION_END <= OFF_END, "P1 outputs overflow the ACT region");
#define SM_G1 0
#define SM_G2 2048
#define SM_GMBS 4096
#define SM_SCW 5120
#define SM_SUBLN 6656
#define SM_FFNCONV 6784
#define SM_FINALG 23680
#define SM_TOTAL 24704

__device__ __forceinline__ Params make_params(const KArgs& a) {
  Params p;
  p.x = a.in[0]; p.c = a.in[1]; p.ctx = a.in[2]; p.c_ctx = a.in[3]; p.w_ada = a.in[4]; p.b_ada = a.in[5];
  p.g1_in = a.in[6]; p.g2_in = a.in[7]; p.w_in = a.in[8]; p.gm_ws = a.in[9]; p.gm_bs_in = a.in[10]; p.sc_w_in = a.in[11];
  p.lq1 = a.in[12]; p.lk1 = a.in[13]; p.lq2 = a.in[14]; p.lk2 = a.in[15]; p.subln_in = a.in[16]; p.w_out = a.in[17];
  p.w_up = a.in[18]; p.ffn_conv_in = a.in[19]; p.w_down = a.in[20]; p.final_g_in = a.in[21];
  p.out = a.out;
  unsigned char* w = a.ws;
  const float* sm = (const float*)(w + OFF_SMALL);
  p.g1 = sm + SM_G1; p.g2 = sm + SM_G2; p.gm_bs = sm + SM_GMBS; p.sc_w = sm + SM_SCW; p.subln = sm + SM_SUBLN;
  p.ffn_conv = sm + SM_FFNCONV; p.final_g = sm + SM_FINALG;
  p.mod = (float*)(w + OFF_MOD); p.lam = (float*)(w + OFF_LAM); p.rope = (float*)(w + OFF_ROPE); p.Xc = (float*)(w + OFF_XC); p.zero = (const h16*)(w + OFF_ZERO); p.bar = (unsigned*)(w + OFF_BAR);
  p.WinT = (h16*)(w + OFF_WINT); p.WoutT = (h16*)(w + OFF_WOUTT); p.WupT = (h16*)(w + OFF_WUPT); p.WdownT = (h16*)(w + OFF_WDOWNT);
  p.Ws16 = (h16*)(w + OFF_WS16); p.Fn = (h16*)(w + OFF_FN); p.Fc = (h16*)(w + OFF_FC); p.H16 = (h16*)(w + OFF_H16);
  p.ACT = (h16*)(w + OFF_ACT); p.U16 = (h16*)(w + OFF_U16); p.VTl = (h16*)(w + OFF_VTL); p.VTc = (h16*)(w + OFF_VTC);
  p.ZB = (h16*)(w + OFF_ZB); p.GTl = (h16*)(w + OFF_GTL); p.GTc = (h16*)(w + OFF_GTC); p.Q16 = (h16*)(w + OFF_Q16);
  p.K16 = (h16*)(w + OFF_K16); p.VT16 = (h16*)(w + OFF_VT16);
  return p;
}

__device__ __forceinline__ float gelu_f(float x) {
  const float u = 0.7978845608028654f * (x + 0.044715f * x * x * x);
  return x * __builtin_amdgcn_rcpf(1.f + __expf(-2.f * u));
}
__device__ __forceinline__ float silu_f(float x) { return x * __builtin_amdgcn_rcpf(1.f + __expf(-x)); }
__device__ __forceinline__ h16x4 pack4(float a, float b, float c, float d) {
  h16x4 r; r[0] = (h16)a; r[1] = (h16)b; r[2] = (h16)c; r[3] = (h16)d; return r;
}
#define LAS __attribute__((address_space(3)))
__device__ __forceinline__ int opaque_tid() { int t = threadIdx.x; asm volatile("" : "+v"(t)); return t; }
__device__ __forceinline__ float ldvol(const float* p) { return *(const volatile float*)p; }

template <typename ARowFn>
__device__ __forceinline__ void gemm256(f32x4 (&acc)[8][4], ARowFn arow, const h16* Bt, const int ldb, const int K,
                                        unsigned char* smem, const int tid) {
  const int lane = tid & 63, wid = tid >> 6, wm = wid >> 2, wn = wid & 3;
  const int l15 = lane & 15, g4 = lane >> 4;
  const int lr = tid >> 3, lc = tid & 7;
  const h16* ap[4]; const h16* bp[4];
#pragma unroll
  for (int i = 0; i < 4; ++i) {
    const int r = lr + 64 * i;
    const int gc = (lc ^ ((r >> 1) & 7)) * 8;
    ap[i] = arow(r) + gc;
    bp[i] = Bt + (size_t)r * ldb + gc;
  }
#pragma unroll
  for (int mi = 0; mi < 8; ++mi)
#pragma unroll
    for (int nj = 0; nj < 4; ++nj)
#pragma unroll
      for (int r = 0; r < 4; ++r) acc[mi][nj][r] = 0.f;
  const int nk = K >> 6;
  const int sw = (l15 >> 1) & 7;
  const int arow0 = (wm * 128 + l15) * 128, brow0 = (wn * 64 + l15) * 128;
  LAS unsigned char* lds = (LAS unsigned char*)smem;
  const int wbase = __builtin_amdgcn_readfirstlane(wid) * 1024;
  const int half = __builtin_amdgcn_readfirstlane(wid >> 2);
#define G256_ISSUE(kt) do { const int so_ = ((kt) & 1) * LDS_STAGE;                                                      \
    _Pragma("unroll") for (int i = 0; i < 4; ++i) {                                                                      \
      __builtin_amdgcn_global_load_lds((const unsigned*)(ap[i] + (kt) * 64), (LAS unsigned*)(lds + so_ + wbase + i * 8192), 16, 0, 0); \
      __builtin_amdgcn_global_load_lds((const unsigned*)(bp[i] + (kt) * 64), (LAS unsigned*)(lds + so_ + 32768 + wbase + i * 8192), 16, 0, 0); } } while (0)
#define G256_ISSUE_PART(kt, i) do { const int so_ = ((kt) & 1) * LDS_STAGE;                                              \
    __builtin_amdgcn_global_load_lds((const unsigned*)(ap[i] + (kt) * 64), (LAS unsigned*)(lds + so_ + wbase + (i) * 8192), 16, 0, 0); \
    __builtin_amdgcn_global_load_lds((const unsigned*)(bp[i] + (kt) * 64), (LAS unsigned*)(lds + so_ + 32768 + wbase + (i) * 8192), 16, 0, 0); } while (0)
  __syncthreads();
  G256_ISSUE(0);
  asm volatile("s_waitcnt vmcnt(0)" ::: "memory");
  __syncthreads();
  if (half == 1 && nk > 1) G256_ISSUE_PART(1, 0);
#define G256_BAR() do { __builtin_amdgcn_sched_barrier(0); asm volatile("s_waitcnt lgkmcnt(0)" ::: "memory"); __builtin_amdgcn_s_barrier(); asm volatile("" ::: "memory"); __builtin_amdgcn_sched_barrier(0); } while (0)
#define G256_LOADQ(F_A, F_B, SUB, PART) do {                                                                           \
    const int ch = ((((SUB) * 4) + g4) ^ sw) << 4;                                                                      \
    _Pragma("unroll") for (int mi = 4 * (PART); mi < 4 * (PART) + 4; ++mi) F_A[mi] = *(const h16x8*)(As + arow0 + mi * 16 * 128 + ch); \
    if ((PART) == 0) { _Pragma("unroll") for (int nj = 0; nj < 4; ++nj) F_B[nj] = *(const h16x8*)(Bs + brow0 + nj * 16 * 128 + ch); } } while (0)
#define G256_MMAQ(F_A, F_B, PART) do {                                                                                  \
    _Pragma("unroll") for (int mi = 4 * (PART); mi < 4 * (PART) + 4; ++mi)                                              \
      _Pragma("unroll") for (int nj = 0; nj < 4; ++nj)                                                                  \
        acc[mi][nj] = __builtin_amdgcn_mfma_f32_16x16x32_f16(F_B[nj], F_A[mi], acc[mi][nj], 0, 0, 0); } while (0)
  if (half == 1) G256_BAR();
  for (int t = 0; t < nk; ++t) {
    const unsigned char* As = smem + (t & 1) * LDS_STAGE;
    const unsigned char* Bs = As + 32768;
    {
      const bool i0 = (half == 0) && t + 1 < nk;
      const bool i1 = (half == 1) && t + 1 < nk;
      h16x8 fa[8], fb[4];
      if (i0) G256_ISSUE_PART(t + 1, 0);
      if (i1) G256_ISSUE_PART(t + 1, 1);
      G256_LOADQ(fa, fb, 0, 0);
      G256_BAR();
      if (i0) G256_ISSUE_PART(t + 1, 1);
      if (i1) G256_ISSUE_PART(t + 1, 2);
      G256_MMAQ(fa, fb, 0);
      G256_BAR();
      if (i0) G256_ISSUE_PART(t + 1, 2);
      if (i1) G256_ISSUE_PART(t + 1, 3);
      G256_LOADQ(fa, fb, 0, 1);
      G256_BAR();
      if (i0) G256_ISSUE_PART(t + 1, 3);
      G256_MMAQ(fa, fb, 1);
      G256_BAR();
    }
    {
      h16x8 fa[8], fb[4];
      G256_LOADQ(fa, fb, 1, 0);
      G256_BAR();
      G256_MMAQ(fa, fb, 0);
      G256_BAR();
      G256_LOADQ(fa, fb, 1, 1);
      if (half == 1 && t + 1 < nk) asm volatile("s_waitcnt vmcnt(0)" ::: "memory");
      G256_BAR();
      if (half == 1 && t + 2 < nk) G256_ISSUE_PART(t + 2, 0);
      G256_MMAQ(fa, fb, 1);
      if (half == 0 && t + 1 < nk) asm volatile("s_waitcnt vmcnt(0)" ::: "memory");
      G256_BAR();
    }
  }
  if (half == 0) G256_BAR();
#undef G256_BAR
#undef G256_LOADQ
#undef G256_MMAQ
#undef G256_ISSUE
#undef G256_ISSUE_PART
  __syncthreads();
}

template <typename ColMap>
__device__ __forceinline__ void transpose_strip(const float* W, int ldw, int k0, h16* dst, int ldt, int n0, ColMap cmap,
                                                unsigned char* smem, const int tid) {
  float* tile = (float*)smem;
  __syncthreads();
  {
    const int nl = tid & 63, kq = tid >> 6;
    float v[4][8];
#pragma unroll
    for (int s = 0; s < 4; ++s) {
      const int sc = cmap(n0 + s * 64 + nl);
#pragma unroll
      for (int t = 0; t < 8; ++t) v[s][t] = W[(size_t)(k0 + kq * 8 + t) * ldw + sc];
    }
#pragma unroll
    for (int s = 0; s < 4; ++s)
#pragma unroll
      for (int t = 0; t < 8; ++t) tile[(kq * 8 + t) * 257 + s * 64 + nl] = v[s][t];
  }
  __syncthreads();
  {
    const int n = tid >> 1, ks = (tid & 1) * 32;
    h16* d = dst + (size_t)(n0 + n) * ldt + k0 + ks;
#pragma unroll
    for (int c = 0; c < 4; ++c) {
      h16x8 o;
#pragma unroll
      for (int t = 0; t < 8; ++t) o[t] = (h16)tile[(ks + c * 8 + t) * 257 + n];
      *(h16x8*)(d + c * 8) = o;
    }
  }
}

__device__ void prep_phase(const Params& p, unsigned char* smem, unsigned* queue) {
  const int nA = 192, nB = 256, nC = 128, nD = 128, nE = 704, nF = 352, nG = 2048, nH = 256, nI = 16, nJ = 4, nS = 49, nK = 1;
  const int total = nA + nB + nC + nD + nE + nF + nG + nH + nI + nJ + nS + nK;
  for (int it0 = blockIdx.x; it0 < total; it0 += gridDim.x) {
    const int tid = opaque_tid();
    int it = total - 1 - it0;
    if (it < nA) {
      const int l = it / 96, col0 = (it % 96) * 64;
      float* sv = (float*)smem;
      float* red = sv + 17 * 256;
      const int j = tid & 63, kg = tid >> 6;
      float acc[17];
#pragma unroll
      for (int i = 0; i < 17; ++i) acc[i] = 0.f;
      for (int kc = 0; kc < 4; ++kc) {
        __syncthreads();
        for (int e = tid; e < 17 * 256; e += NTHREADS) {
          const int i = e >> 8, kk = e & 255;
          const float cv = (i < 16) ? p.c[i * 1024 + kc * 256 + kk] : p.c_ctx[kc * 256 + kk];
          sv[e] = silu_f(cv);
        }
        __syncthreads();
        const float* wp = p.w_ada + ((size_t)l * 1024 + kc * 256 + kg * 32) * 6144 + col0 + j;
#pragma unroll 8
        for (int t = 0; t < 32; ++t) {
          const float w = wp[(size_t)t * 6144];
#pragma unroll
          for (int i = 0; i < 17; ++i) acc[i] += sv[i * 256 + kg * 32 + t] * w;
        }
      }
      __syncthreads();
#pragma unroll
      for (int i = 0; i < 17; ++i) red[(kg * 17 + i) * 64 + j] = acc[i];
      __syncthreads();
      for (int e = tid; e < 17 * 64; e += NTHREADS) {
        const int i = e >> 6, jj = e & 63;
        float s = 0.f;
#pragma unroll
        for (int g = 0; g < 8; ++g) s += red[(g * 17 + i) * 64 + jj];
        p.mod[(size_t)(l * 17 + i) * 6144 + col0 + jj] = s + p.b_ada[l * 6144 + col0 + jj];
      }
      __syncthreads();
      continue;
    }
    it -= nA;
    if (it < nB) {
      const int l = it / 128, r = it % 128, kt = r / 8; int ns = r % 8; if (ns >= 5) ns += 2;
      transpose_strip(p.w_in + (size_t)l * 1024 * 2304, 2304, kt * 64, p.WinT + (size_t)l * ZC * 1024, 1024, ns * 256,
                      [](int n) { return n < 1280 ? n : n - 256; }, smem, tid);
      continue;
    }
    it -= nB;
    if (it < nC) {
      const int l = it / 64, r = it % 64, h = r / 16, k0 = (r % 16) * 64;
      float* tile = (float*)smem;
      float* ct = tile + 64 * 65;
      float* st = ct + 64;
      __syncthreads();
      {
        const int nl = tid & 63, kq = tid >> 6;
        const float* W = p.w_in + (size_t)l * 1024 * 2304;
#pragma unroll
        for (int t = 0; t < 8; ++t) {
          const int k = kq * 8 + t;
          tile[k * 65 + nl] = W[(size_t)(k0 + k) * 2304 + 1280 + h * 64 + nl];
        }
        if (tid < 64) { ct[tid] = cospif((float)tid / 32.f) * 0.125f; st[tid] = sinpif((float)tid / 32.f) * 0.125f; }
      }
      __syncthreads();
      {
        const int k2 = tid & 63, kq = tid >> 6;
        h16* dc = p.WinT + ((size_t)l * ZC + 1280 + h * 64 + k2) * 1024 + k0;
        h16* ds = p.WinT + ((size_t)l * ZC + 1536 + h * 64 + k2) * 1024 + k0;
        for (int t = 0; t < 8; ++t) {
          const int k = kq * 8 + t;
          float ac = 0.f, as = 0.f;
#pragma unroll 8
          for (int d = 0; d < 64; ++d) {
            const float w = tile[k * 65 + d];
            const int idx = (k2 * d) & 63;
            ac += w * ct[idx]; as += w * st[idx];
          }
          dc[k] = (h16)ac; ds[k] = (h16)as;
        }
      }
      __syncthreads();
      continue;
    }
    it -= nC;
    if (it < nD) {
      const int l = it / 64, r = it % 64, kt = r / 4, ns = r % 4;
      transpose_strip(p.w_out + (size_t)l * 1024 * 1024, 1024, kt * 64, p.WoutT + (size_t)l * 1024 * 1024, 1024, ns * 256,
                      [](int n) { return n; }, smem, tid);
      continue;
    }
    it -= nD;
    if (it < nE) {
      const int l = it / 352, r = it % 352, kt = r / 22, ns = r % 22;
      transpose_strip(p.w_up + (size_t)l * 1024 * 5632, 5632, kt * 64, p.WupT + (size_t)l * 5632 * 1024, 1024, ns * 256,
                      [](int n) { const int t = n >> 8, cc = n & 255; const int j = t * 128 + (cc >> 6) * 32 + ((cc >> 5) & 1) * 16 + (cc & 15);
                                  return ((cc >> 4) & 1) ? DFF + j : j; }, smem, tid);
      continue;
    }
    it -= nE;
    if (it < nF) {
      const int l = it / 176, r = it % 176, kt = r / 4, ns = r % 4;
      transpose_strip(p.w_down + (size_t)l * DFF * 1024, 1024, kt * 64, p.WdownT + (size_t)l * 1024 * DFF, DFF, ns * 256,
                      [](int n) { return n; }, smem, tid);
      continue;
    }
    it -= nF;
    if (it < nG) {
      const int k1 = it;
      const float sc = 0.02209708691207961f;
      h16x8 v0;
#pragma unroll
      for (int e = 0; e < 8; ++e) {
        const int kk = tid * 8 + e;
        const int n = kk & 2047;
        const int m = (k1 * n) & 2047;
        const float a = (float)m / 1024.f;
        v0[e] = (h16)((kk < 2048) ? cospif(a) * sc : -sinpif(a) * sc);
      }
      *(h16x8*)(p.Fn + (size_t)k1 * 4096 + tid * 8) = v0;
      continue;
    }
    it -= nG;
    if (it < nH) {
      const int k1 = it;
      const int kk = tid;
      const int n = kk & 255;
      const int m = (k1 * n) & 255;
      const float a = (float)m / 128.f;
      p.Fc[(size_t)k1 * 512 + kk] = (h16)((kk < 256) ? cospif(a) * 0.0625f : -sinpif(a) * 0.0625f);
      continue;
    }
    it -= nH;
    if (it < nI) {
      const int base = it * 8192 + tid * 16;
#pragma unroll
      for (int e = 0; e < 16; ++e) p.Ws16[base + e] = (h16)p.gm_ws[base + e];
      continue;
    }
    it -= nI;
    if (it < nJ) {
      const int n = it * 512 + tid;
      const float row = (float)(n >> 6), col = (float)(n & 63);
      float* d = p.rope + (size_t)n * 32;
#pragma unroll
      for (int i = 0; i < 8; ++i) {
        const float invf = powf(10000.f, -(float)(2 * i) / 16.f);
        const float ar = row * invf, ac = col * invf;
        d[i] = cosf(ar); d[8 + i] = sinf(ar); d[16 + i] = cosf(ac); d[24 + i] = sinf(ac);
      }
      continue;
    }
    it -= nJ;
    if (it < nS) {
      const int idx = it * 512 + tid;
      if (idx < SM_TOTAL) {
        float v;
        if (idx < SM_G2) v = p.g1_in[idx - SM_G1];
        else if (idx < SM_GMBS) v = p.g2_in[idx - SM_G2];
        else if (idx < SM_SCW) v = p.gm_bs_in[idx - SM_GMBS];
        else if (idx < SM_SUBLN) v = p.sc_w_in[idx - SM_SCW];
        else if (idx < SM_FFNCONV) v = p.subln_in[idx - SM_SUBLN];
        else if (idx < SM_FINALG) v = p.ffn_conv_in[idx - SM_FFNCONV];
        else v = p.final_g_in[idx - SM_FINALG];
        ((float*)p.g1)[idx] = v;
      }
      continue;
    }
    it -= nS;
    {
      for (int e = tid; e < 2048; e += NTHREADS) ((unsigned*)p.zero)[e] = 0u;
      if (tid < 2) {
        const int l = tid;
        float s1 = 0.f, s2 = 0.f;
        for (int i = 0; i < 32; ++i) { s1 += p.lq1[l * 32 + i] * p.lk1[l * 32 + i]; s2 += p.lq2[l * 32 + i] * p.lk2[l * 32 + i]; }
        const float lam_init = 0.8f - 0.6f * expf(-0.3f * (float)l);
        p.lam[l] = expf(s1) - expf(s2) + lam_init;
        p.lam[2 + l] = lam_init;
      }
    }
  }
}

__device__ __forceinline__ float wave_sum(float v) {
#pragma unroll
  for (int o = 32; o >= 1; o >>= 1) v += __shfl_xor(v, o);
  return v;
}

__device__ void norm_phase(const Params& p, int l, int which  , bool from_input, int nrows) {
  const int tid_ = opaque_tid(); const int lane = tid_ & 63, wid = tid_ >> 6;
  const float* gv = (which == 0 ? p.g1 : p.g2) + l * 1024;
  const int sh_off = which == 0 ? 0 : 3072, sc_off = which == 0 ? 1024 : 4096;
  for (int row = blockIdx.x * NWAVES + wid; row < nrows; row += gridDim.x * NWAVES) {
    const float* xr;
    if (row < NLAT) xr = (from_input ? p.x : p.out) + (size_t)row * 1024;
    else xr = (from_input ? p.ctx : p.Xc) + (size_t)(row - NLAT) * 1024;
    f32x4 v[4];
    float ss = 0.f;
#pragma unroll
    for (int i = 0; i < 4; ++i) {
      v[i] = *(const f32x4*)(xr + i * 256 + lane * 4);
      ss += v[i][0] * v[i][0] + v[i][1] * v[i][1] + v[i][2] * v[i][2] + v[i][3] * v[i][3];
    }
    ss = wave_sum(ss);
    const float rstd = rsqrtf(ss * (1.f / 1024.f) + EPS);
    const int mi = row < NLAT ? (row >> 11) : 16;
    const float* md = p.mod + (size_t)(l * 17 + mi) * 6144;
#pragma unroll
    for (int i = 0; i < 4; ++i) {
      const int k = i * 256 + lane * 4;
      const f32x4 g = *(const f32x4*)(gv + k), sc = *(const f32x4*)(md + sc_off + k), sh = *(const f32x4*)(md + sh_off + k);
      float y[4];
#pragma unroll
      for (int e = 0; e < 4; ++e) y[e] = v[i][e] * rstd * g[e] * (1.f + sc[e]) + sh[e];
      *(h16x4*)(p.H16 + (size_t)row * 1024 + k) = pack4(y[0], y[1], y[2], y[3]);
    }
  }
}

__device__ void final_norm_phase(const Params& p) {
  const int tid_ = opaque_tid(); const int lane = tid_ & 63, wid = tid_ >> 6;
  for (int row = blockIdx.x * NWAVES + wid; row < NLAT; row += gridDim.x * NWAVES) {
    float* xr = p.out + (size_t)row * 1024;
    f32x4 v[4];
    float ss = 0.f;
#pragma unroll
    for (int i = 0; i < 4; ++i) {
      v[i] = *(const f32x4*)(xr + i * 256 + lane * 4);
      ss += v[i][0] * v[i][0] + v[i][1] * v[i][1] + v[i][2] * v[i][2] + v[i][3] * v[i][3];
    }
    ss = wave_sum(ss);
    const float rstd = rsqrtf(ss * (1.f / 1024.f) + EPS);
#pragma unroll
    for (int i = 0; i < 4; ++i) {
      const int k = i * 256 + lane * 4;
      const f32x4 g = *(const f32x4*)(p.final_g + k);
      f32x4 y;
#pragma unroll
      for (int e = 0; e < 4; ++e) y[e] = v[i][e] * rstd * g[e];
      *(f32x4*)(xr + k) = y;
    }
  }
}

__device__ __forceinline__ void rope16(f32x4& a, const float* tab, const int g4, const bool on) {
  f32x4 pr;
#pragma unroll
  for (int e = 0; e < 4; ++e) pr[e] = __shfl_xor(a[e], 32);
  if (on) {
    const f32x4 c = *(const f32x4*)(tab), s = *(const f32x4*)(tab + 8);
#pragma unroll
    for (int e = 0; e < 4; ++e) a[e] = (g4 < 2) ? (a[e] * c[e] - pr[e] * s[e]) : (a[e] * c[e] + pr[e] * s[e]);
  }
}

__device__ __forceinline__ int vblock() { return (blockIdx.x & 7) * (gridDim.x >> 3) + (blockIdx.x >> 3); }
__device__ __forceinline__ void tile_map(int it, int nMt, int nNt, int PM, int& mt, int& nt) {
  const int per = PM * nNt;
  const int panel = it / per, rem = it - panel * per, m0 = panel * PM;
  const int pmw = (nMt - m0) < PM ? (nMt - m0) : PM;
  nt = rem / pmw; mt = m0 + rem % pmw;
}
#define TID_DECL const int tid = opaque_tid(), lane = tid & 63, wid = tid >> 6, wm = wid >> 2, wn = wid & 3, l15 = lane & 15, g4 = lane >> 4;

__device__ void p1_phase(const Params& p, int l, unsigned char* smem) {
  const h16* WT = p.WinT + (size_t)l * ZC * 1024;
  const int nmain = (l == 0) ? 144 * 10 : 128 * 10, nextra = (l == 0) ? 0 : 32;
  for (int t = vblock(); t < nmain + nextra; t += gridDim.x) {
    TID_DECL
    int tm, tn;
    if (t < nmain) tile_map(t, (l == 0) ? 144 : 128, 10, 16, tm, tn);
    else { const int u = t - nmain; tm = 128 + (u & 15); tn = 8 + (u >> 4); }
    f32x4 acc[8][4];
    const h16* Abase = p.H16 + (size_t)tm * 256 * 1024;
    gemm256(acc, [&](int i) { return Abase + (size_t)i * 1024; }, WT + (size_t)tn * 256 * 1024, 1024, 1024, smem, tid);
    const int g = tn;
    const int cgw = wn * 64 + 4 * g4;
#pragma unroll
    for (int mi = 0; mi < 8; ++mi) {
      const int R = tm * 256 + wm * 128 + mi * 16 + l15;
      const bool isctx = R >= NLAT;
      int b, pos;
      if (!isctx) { b = R >> 11; pos = R & 2047; } else { const int rc = R - NLAT; b = rc >> 8; pos = rc & 255; }
      if (g == 0) {
#pragma unroll
        for (int nj = 0; nj < 4; ++nj) {
          const f32x4& a = acc[mi][nj];
          *(h16x4*)(p.U16 + (size_t)R * 256 + cgw + nj * 16) = pack4(gelu_f(a[0]), gelu_f(a[1]), gelu_f(a[2]), gelu_f(a[3]));
        }
      } else if (g == 1) {
        float ss = 0.f;
#pragma unroll
        for (int nj = 0; nj < 4; ++nj)
#pragma unroll
          for (int e = 0; e < 4; ++e) { const float v = gelu_f(acc[mi][nj][e]); acc[mi][nj][e] = v; ss += v * v; }
        ss += __shfl_xor(ss, 16);
        ss += __shfl_xor(ss, 32);
        const float rinv = rsqrtf(ss * (1.f / 64.f) + EPS);
        const int head = wn;
        h16* base; int stride;
        if (!isctx) { base = p.VTl + ((size_t)(head * 1024 + b * 64) * 2048 + pos); stride = 2048; }
        else { base = p.VTc + ((size_t)(head * 1024 + b * 64) * 256 + pos); stride = 256; }
#pragma unroll
        for (int nj = 0; nj < 4; ++nj)
#pragma unroll
          for (int e = 0; e < 4; ++e) {
            const int d = nj * 16 + 4 * g4 + e;
            base[(size_t)d * stride] = (h16)(acc[mi][nj][e] * rinv);
          }
      } else if (g <= 4) {
#pragma unroll
        for (int nj = 0; nj < 4; ++nj) {
          const f32x4& a = acc[mi][nj];
          *(h16x4*)(p.ZB + (size_t)R * 768 + (g - 2) * 256 + cgw + nj * 16) = pack4(a[0], a[1], a[2], a[3]);
        }
      } else if (g <= 6) {
        h16* base; int stride;
        if (!isctx) { base = p.GTl + ((size_t)(b * 256 + cgw) * 4096 + (g == 6 ? 2048 : 0) + pos); stride = 4096; }
        else { base = p.GTc + ((size_t)(b * 256 + cgw) * 512 + (g == 6 ? 256 : 0) + pos); stride = 512; }
#pragma unroll
        for (int nj = 0; nj < 4; ++nj)
#pragma unroll
          for (int e = 0; e < 4; ++e) base[(size_t)(nj * 16 + e) * stride] = (h16)acc[mi][nj][e];
      } else if (g == 7) {
        const float qs = 0.17677669529663687f * 1.4426950408889634f;
#pragma unroll
        for (int nj = 0; nj < 4; ++nj) {
          rope16(acc[mi][nj], p.rope + (size_t)pos * 32 + (nj & 1) * 16 + 4 * (g4 & 1), g4, !isctx);
          const f32x4& a = acc[mi][nj];
          *(h16x4*)(p.Q16 + (size_t)R * 256 + cgw + nj * 16) = pack4(a[0] * qs, a[1] * qs, a[2] * qs, a[3] * qs);
        }
      } else if (g == 8) {
        const int key = isctx ? pos : 256 + pos;
#pragma unroll
        for (int nj = 0; nj < 4; ++nj) {
          rope16(acc[mi][nj], p.rope + (size_t)pos * 32 + (nj & 1) * 16 + 4 * (g4 & 1), g4, !isctx);
          const f32x4& a = acc[mi][nj];
          *(h16x4*)(p.K16 + ((size_t)b * NKEY + key) * 256 + cgw + nj * 16) = pack4(a[0], a[1], a[2], a[3]);
        }
      } else {
        const int key = isctx ? pos : 256 + pos;
        h16* base = p.VT16 + ((size_t)(b * 256 + cgw) * NKEY + key);
#pragma unroll
        for (int nj = 0; nj < 4; ++nj)
#pragma unroll
          for (int e = 0; e < 4; ++e) base[(size_t)(nj * 16 + e) * NKEY] = (h16)acc[mi][nj][e];
      }
    }
  }
}

__device__ void attn_unit(const Params& p, int l, int b, int h, int qrow0, int nkeys, unsigned char* smem, const int tid) {
  const int lane = tid & 63, w = tid >> 6, l31 = lane & 31, hf = lane >> 5;
  const h16* Kbase = p.K16 + (size_t)b * NKEY * 256 + h * 64;
  const h16* Vbase = p.VT16 + (size_t)(b * 256 + h * 64) * NKEY;
  const int qrow = qrow0 + w * 32 + l31;
  h16x8 qf0[2][2];
#pragma unroll
  for (int m = 0; m < 2; ++m)
#pragma unroll
    for (int s = 0; s < 2; ++s) qf0[m][s] = *(const h16x8*)(p.Q16 + (size_t)qrow * 256 + h * 64 + m * 32 + s * 16 + hf * 8);
  unsigned char* Qs = smem + 49152 + tid * 16;
  f32x16 O[2][2];
#pragma unroll
  for (int m = 0; m < 2; ++m)
#pragma unroll
    for (int dt = 0; dt < 2; ++dt)
#pragma unroll
      for (int r = 0; r < 16; ++r) O[m][dt][r] = 0.f;
  float mrun[2] = {0.f, 0.f}, lsum[2] = {0.f, 0.f};
  const int sr = tid >> 3, sc = tid & 7;
  const int gc = (sc ^ ((sr >> 1) & 7)) * 8;
  const h16* kp = Kbase + (size_t)sr * 256 + gc;
  const h16* vp = Vbase + (size_t)sr * NKEY + gc;
  LAS unsigned char* lds = (LAS unsigned char*)smem;
  const int wbase = __builtin_amdgcn_readfirstlane(w) * 1024;
  const int nt = nkeys >> 6;
#define ATT_ISSUE(kt, st) do {                                                                                           \
    __builtin_amdgcn_global_load_lds((const unsigned*)(kp + (size_t)(kt) * 64 * 256), (LAS unsigned*)(lds + (st) * 16384 + wbase), 16, 0, 0); \
    __builtin_amdgcn_global_load_lds((const unsigned*)(vp + (kt) * 64), (LAS unsigned*)(lds + (st) * 16384 + 8192 + wbase), 16, 0, 0); } while (0)
  const int ksw = (l31 >> 1) & 7;
#define ATT_QK(S, Ks_, m_, sub_) do {                                                                                    \
    const float nm_ = -mrun[m_];                                                                                         \
    _Pragma("unroll") for (int r = 0; r < 16; ++r) S[r] = nm_;                                                           \
    _Pragma("unroll") for (int s = 0; s < 2; ++s) {                                                                      \
      const int ch = (((m_) * 4 + s * 2 + hf) ^ ksw) << 4;                                                               \
      const h16x8 kf = *(const h16x8*)((Ks_) + ((sub_) * 32 + l31) * 128 + ch);                                          \
      const h16x8 qv = *(const h16x8*)(Qs + ((m_) * 2 + s) * 8192);                                                      \
      S = __builtin_amdgcn_mfma_f32_32x32x16_f16(kf, qv, S, 0, 0, 0); } } while (0)
  __syncthreads();
#pragma unroll
  for (int m = 0; m < 2; ++m)
#pragma unroll
    for (int s = 0; s < 2; ++s) *(h16x8*)(Qs + (m * 2 + s) * 8192) = qf0[m][s];
  ATT_ISSUE(0, 0);
  if (nt > 1) ATT_ISSUE(1, 1);
  asm volatile("s_waitcnt vmcnt(0)" ::: "memory");
  __syncthreads();
  f32x16 scur[2];
  ATT_QK(scur[0], smem, 0, 0);
  ATT_QK(scur[1], smem, 1, 0);
  int st = 0;
  for (int kt = 0; kt < nt; ++kt) {
    const int st1 = (st == 2) ? 0 : st + 1, st2 = (st1 == 2) ? 0 : st1 + 1;
    if (kt + 2 < nt) ATT_ISSUE(kt + 2, st2);
    const unsigned char* Kc = smem + st * 16384;
    const unsigned char* Vs = Kc + 8192;
    const unsigned char* Kn = smem + st1 * 16384;
#pragma unroll
    for (int sub = 0; sub < 2; ++sub) {
      const bool more = (sub == 0) || (kt + 1 < nt);
      const bool first = (kt == 0) && (sub == 0);
#pragma unroll
      for (int m = 0; m < 2; ++m) {
        f32x16 sn;
        if (more) { if (sub == 0) ATT_QK(sn, Kc, m, 1); else ATT_QK(sn, Kn, m, 0); }
        f32x16& s0 = scur[m];
        h16x8 pf[2];
        {
          float mx = s0[0];
#pragma unroll
          for (int r = 1; r < 16; ++r) mx = fmaxf(mx, s0[r]);
          mx = fmaxf(mx, __shfl_xor(mx, 32));
          if (__any(first || (mx > 8.f))) {
            const float delta = first ? mx : fmaxf(mx, 0.f);
            const float alpha = first ? 1.f : __builtin_amdgcn_exp2f(-delta);
            mrun[m] += delta;
            lsum[m] *= alpha;
#pragma unroll
            for (int r = 0; r < 16; ++r) s0[r] -= delta;
            if (more) {
#pragma unroll
              for (int r = 0; r < 16; ++r) sn[r] -= delta;
            }
#pragma unroll
            for (int dt = 0; dt < 2; ++dt)
#pragma unroll
              for (int r = 0; r < 16; ++r) O[m][dt][r] *= alpha;
          }
          float ps = 0.f;
#pragma unroll
          for (int r = 0; r < 16; ++r) { s0[r] = __builtin_amdgcn_exp2f(s0[r]); ps += s0[r]; }
          lsum[m] += ps;
#pragma unroll
          for (int sp = 0; sp < 2; ++sp) {
            u32x4 w0;
#pragma unroll
            for (int j = 0; j < 4; ++j)
              w0[j] = __builtin_bit_cast(unsigned, __builtin_amdgcn_cvt_pkrtz(s0[8 * sp + 2 * j], s0[8 * sp + 2 * j + 1]));
            pf[sp] = __builtin_bit_cast(h16x8, w0);
          }
        }
#pragma unroll
        for (int dt = 0; dt < 2; ++dt)
#pragma unroll
          for (int sp = 0; sp < 2; ++sp) {
            const int gA = sub * 8 + 4 * sp + hf, gB = gA + 2;
            const int vrow = (dt * 32 + l31) * 128;
            const h16x4 lo = *(const h16x4*)(Vs + vrow + ((((gA >> 1) ^ ksw) << 4) | ((gA & 1) << 3)));
            const h16x4 hi = *(const h16x4*)(Vs + vrow + ((((gB >> 1) ^ ksw) << 4) | ((gB & 1) << 3)));
            h16x8 vf;
            vf[0] = lo[0]; vf[1] = lo[1]; vf[2] = lo[2]; vf[3] = lo[3]; vf[4] = hi[0]; vf[5] = hi[1]; vf[6] = hi[2]; vf[7] = hi[3];
            O[m][dt] = __builtin_amdgcn_mfma_f32_32x32x16_f16(vf, pf[sp], O[m][dt], 0, 0, 0);
          }
        if (more) s0 = sn;
      }
    }
    asm volatile("s_waitcnt vmcnt(0)" ::: "memory");
    __syncthreads();
    st = st1;
  }
#undef ATT_ISSUE
#undef ATT_QK
  const float lam = ldvol(p.lam + l), lam_init = ldvol(p.lam + 2 + l);
  float l0 = lsum[0] + __shfl_xor(lsum[0], 32), l1 = lsum[1] + __shfl_xor(lsum[1], 32);
  const float i0 = 1.f / l0, i1 = lam / l1;
  float ss = 0.f;
#pragma unroll
  for (int dt = 0; dt < 2; ++dt)
#pragma unroll
    for (int r = 0; r < 16; ++r) { const float o = O[0][dt][r] * i0 - O[1][dt][r] * i1; O[0][dt][r] = o; ss += o * o; }
  ss += __shfl_xor(ss, 32);
  const float rinv = rsqrtf(ss * (1.f / 64.f) + EPS) * (1.f - lam_init);
  h16* orow = p.H16 + (size_t)qrow * 1024 + 768 + h * 64;
#pragma unroll
  for (int dt = 0; dt < 2; ++dt)
#pragma unroll
    for (int q = 0; q < 4; ++q) {
      const int d = dt * 32 + q * 8 + hf * 4;
      const f32x4 g = *(const f32x4*)(p.subln + l * 64 + d);
      *(h16x4*)(orow + d) = pack4(O[0][dt][4 * q] * rinv * g[0], O[0][dt][4 * q + 1] * rinv * g[1],
                                  O[0][dt][4 * q + 2] * rinv * g[2], O[0][dt][4 * q + 3] * rinv * g[3]);
    }
}

__device__ void p2_phase(const Params& p, int l, unsigned char* smem, unsigned* queue) {
  const bool ctxon = (l == 0);
  const int nDl = 80, nAl = 512, nAc = ctxon ? 64 : 0, nDc = ctxon ? 16 : 0, nGl = 256, nGc = ctxon ? 32 : 0;
  const int nBrows = ctxon ? NTOK : NLAT, nB = nBrows / 16;
  const int total = nDl + nAl + nAc + nDc + nGl + nGc + nB;
  h16* MIX = p.H16;
  int* qslot = (int*)(smem + LDS_BYTES - 16);
  for (;;) {
    TID_DECL
    __syncthreads();
    if (tid == 0) *qslot = (int)__hip_atomic_fetch_add(queue, 1u, __ATOMIC_RELAXED, __HIP_MEMORY_SCOPE_AGENT);
    __syncthreads();
    int it = *qslot;
    if (it >= total) break;
    if (it < nDl) {
      const int tm = it >> 4, tn = it & 15;
      f32x4 acc[8][4];
      const h16* Ab = p.Fn + (size_t)tm * 256 * 4096;
      gemm256(acc, [&](int i) { return Ab + (size_t)i * 4096; }, p.GTl + (size_t)tn * 256 * 4096, 4096, 4096, smem, tid);
      const int b = tn, c0 = wn * 64 + 4 * g4;
#pragma unroll
      for (int mi = 0; mi < 8; ++mi) {
        const int k1 = tm * 256 + wm * 128 + mi * 16 + l15;
        h16* o = MIX + ((size_t)b * 2048 + k1) * 1024 + 512 + c0;
#pragma unroll
        for (int nj = 0; nj < 4; ++nj) {
          const f32x4& a = acc[mi][nj];
          *(h16x4*)(o + nj * 16) = pack4(a[0], a[1], a[2], a[3]);
        }
        if (k1 >= 1 && k1 <= 768) {
          h16* om = MIX + ((size_t)b * 2048 + (2048 - k1)) * 1024 + 512 + wn * 64;
#pragma unroll
          for (int nj = 0; nj < 4; ++nj)
#pragma unroll
            for (int e = 0; e < 4; ++e) om[(64 - (nj * 16 + 4 * g4 + e)) & 63] = (h16)acc[mi][nj][e];
        }
      }
      continue;
    }
    it -= nDl;
    if (it < nAl) {
      const int qb = it & 7, h = (it >> 3) & 3, b = it >> 5;
      attn_unit(p, l, b, h, b * 2048 + qb * 256, NKEY, smem, tid);
      continue;
    }
    it -= nAl;
    if (it < nAc) {
      const int h = it & 3, b = it >> 2;
      attn_unit(p, l, b, h, NLAT + b * 256, 256, smem, tid);
      continue;
    }
    it -= nAc;
    if (it < nDc) {
      const int tn = it;
      f32x4 acc[8][4];
      gemm256(acc, [&](int i) { return p.Fc + (size_t)i * 512; }, p.GTc + (size_t)tn * 256 * 512, 512, 512, smem, tid);
      const int b = tn, c0 = wn * 64 + 4 * g4;
#pragma unroll
      for (int mi = 0; mi < 8; ++mi) {
        const int k1 = wm * 128 + mi * 16 + l15;
        h16* o = MIX + ((size_t)NLAT + b * 256 + k1) * 1024 + 512 + c0;
#pragma unroll
        for (int nj = 0; nj < 4; ++nj) {
          const f32x4& a = acc[mi][nj];
          *(h16x4*)(o + nj * 16) = pack4(a[0], a[1], a[2], a[3]);
        }
      }
      continue;
    }
    it -= nDc;
    if (it < nGl + nGc) {
      const bool isc = it >= nGl;
      int h, c, tn;
      if (!isc) { tn = it & 3; c = (it >> 2) & 15; h = it >> 6; }
      else { const int u = it - nGl; tn = u & 3; c = (u >> 2) & 1; h = u >> 3; }
      const int ldb = isc ? 256 : 2048;
      const h16* Bt = (isc ? p.VTc : p.VTl) + (size_t)(h * 1024 + tn * 256) * ldb + c * 128;
      const h16* Ab = p.Ws16 + (size_t)(l * 4 + h) * 128 * 128;
      f32x4 acc[8][4];
      gemm256(acc, [&](int i) { return i < 128 ? Ab + (size_t)i * 128 : p.zero; }, Bt, ldb, 128, smem, tid);
      if (wm == 0) {
#pragma unroll
        for (int mi = 0; mi < 8; ++mi) {
          const int pp = mi * 16 + l15;
          const float bias = p.gm_bs[(l * 4 + h) * 128 + pp];
#pragma unroll
          for (int nj = 0; nj < 4; ++nj) {
            const int ng = tn * 256 + wn * 64 + nj * 16;
            const int b = ng >> 6, d = (ng & 63) + 4 * g4;
            const size_t R = isc ? ((size_t)NLAT + b * 256 + c * 128 + pp) : ((size_t)b * 2048 + c * 128 + pp);
            const h16x4 u = *(const h16x4*)(p.U16 + R * 256 + h * 64 + d);
            const f32x4& a = acc[mi][nj];
            *(h16x4*)(MIX + R * 1024 + h * 64 + d) =
                pack4((a[0] + bias) * (float)u[0], (a[1] + bias) * (float)u[1], (a[2] + bias) * (float)u[2], (a[3] + bias) * (float)u[3]);
          }
        }
      }
      continue;
    }
    it -= nGl + nGc;
    {
      const int R = it * 16 + (tid >> 5);
      const int j0 = (tid & 31) * 8;
      int pos, len;
      if (R < NLAT) { pos = R & 2047; len = 2048; } else { pos = (R - NLAT) & 255; len = 256; }
      const h16* zr = p.ZB + (size_t)R * 768;
      float P[3][8];
#pragma unroll
      for (int dlt = 0; dlt < 3; ++dlt) {
        const int pp = pos + dlt - 1;
        if (pp >= 0 && pp < len) {
          const h16x8 bx = *(const h16x8*)(zr + (dlt - 1) * 768 + j0);
          const h16x8 bc = *(const h16x8*)(zr + (dlt - 1) * 768 + 512 + j0);
#pragma unroll
          for (int e = 0; e < 8; ++e) P[dlt][e] = (float)bx[e] * (float)bc[e];
        } else {
#pragma unroll
          for (int e = 0; e < 8; ++e) P[dlt][e] = 0.f;
        }
      }
      const h16x8 bb = *(const h16x8*)(zr + 256 + j0);
      const float* w = p.sc_w + l * 768 + j0;
      h16x8 o;
#pragma unroll
      for (int e = 0; e < 8; ++e)
        o[e] = (h16)((float)bb[e] * (w[e] * P[0][e] + w[256 + e] * P[1][e] + w[512 + e] * P[2][e]));
      *(h16x8*)(MIX + (size_t)R * 1024 + 256 + j0) = o;
    }
  }
}

__device__ void resid_gemm_phase(const Params& p, int l, int which  , bool from_input, int nrows,
                                 unsigned char* smem) {
  const int ntiles = (nrows / 256) * 4;
  const h16* A = which == 0 ? p.H16 : p.ACT;
  const int K = which == 0 ? 1024 : DFF;
  const h16* WT = which == 0 ? p.WoutT + (size_t)l * 1024 * 1024 : p.WdownT + (size_t)l * 1024 * DFF;
  const int goff = which == 0 ? 2048 : 5120;
  for (int t = vblock(); t < ntiles; t += gridDim.x) {
    TID_DECL
    int tm, tn;
    tile_map(t, nrows / 256, 4, 8, tm, tn);
    f32x4 acc[8][4];
    const h16* Ab = A + (size_t)tm * 256 * K;
    gemm256(acc, [&](int i) { return Ab + (size_t)i * K; }, WT + (size_t)tn * 256 * K, K, K, smem, tid);
#pragma unroll
    for (int mi = 0; mi < 8; ++mi) {
      const int R = tm * 256 + wm * 128 + mi * 16 + l15;
      const float* xin; float* xo; int mod_i;
      if (R < NLAT) { xin = (from_input ? p.x : p.out) + (size_t)R * 1024; xo = p.out + (size_t)R * 1024; mod_i = R >> 11; }
      else { xin = (from_input ? p.ctx : p.Xc) + (size_t)(R - NLAT) * 1024; xo = p.Xc + (size_t)(R - NLAT) * 1024; mod_i = 16; }
      const float* gt = p.mod + (size_t)(l * 17 + mod_i) * 6144 + goff;
#pragma unroll
      for (int nj = 0; nj < 4; ++nj) {
        const int n = tn * 256 + wn * 64 + nj * 16 + 4 * g4;
        const f32x4 xi = *(const f32x4*)(xin + n), gg = *(const f32x4*)(gt + n);
        const f32x4& a = acc[mi][nj];
        f32x4 y;
#pragma unroll
        for (int e = 0; e < 4; ++e) y[e] = xi[e] + gg[e] * a[e];
        *(f32x4*)(xo + n) = y;
      }
    }
  }
}

__device__ void p4_phase(const Params& p, int l, int nrows, unsigned char* smem) {
  const int nmt = (nrows + 253) / 254;
  const int ntiles = nmt * 22;
  const h16* WT = p.WupT + (size_t)l * 5632 * 1024;
  const float* cw = p.ffn_conv + (size_t)l * 3 * DFF;
  h16* abuf = (h16*)smem;
  for (int it = vblock(); it < ntiles; it += gridDim.x) {
    TID_DECL
    int nt, t;
    tile_map(it, nmt, 22, 16, t, nt);
    const int R0 = 254 * t - 1;
    f32x4 acc[8][4];
    gemm256(acc, [&](int i) -> const h16* { const int R = R0 + i; return (R >= 0 && R < nrows) ? p.H16 + (size_t)R * 1024 : p.zero; },
            WT + (size_t)nt * 256 * 1024, 1024, 1024, smem, tid);
#pragma unroll
    for (int mi = 0; mi < 8; ++mi) {
      const int m = wm * 128 + mi * 16 + l15;
#pragma unroll
      for (int pj = 0; pj < 2; ++pj)
        *(h16x4*)(abuf + m * 136 + wn * 32 + pj * 16 + 4 * g4) =
            pack4(acc[mi][2 * pj][0], acc[mi][2 * pj][1], acc[mi][2 * pj][2], acc[mi][2 * pj][3]);
    }
    __syncthreads();
#pragma unroll
    for (int mi = 0; mi < 8; ++mi) {
      const int m = wm * 128 + mi * 16 + l15;
      const int R = R0 + m;
      if (m >= 1 && m <= 254 && R < nrows) {
        int ps, len;
        if (R < NLAT) { ps = R & 2047; len = 2048; } else { ps = (R - NLAT) & 255; len = 256; }
        const float mp = (ps == 0) ? 0.f : 1.f, mn = (ps == len - 1) ? 0.f : 1.f;
#pragma unroll
        for (int pj = 0; pj < 2; ++pj) {
          const int ja = wn * 32 + pj * 16 + 4 * g4;
          const int j = nt * 128 + ja;
          const h16x4 ap = *(const h16x4*)(abuf + (m - 1) * 136 + ja), an = *(const h16x4*)(abuf + (m + 1) * 136 + ja);
          const f32x4 w0 = *(const f32x4*)(cw + j), w1 = *(const f32x4*)(cw + DFF + j), w2 = *(const f32x4*)(cw + 2 * DFF + j);
          float y[4];
#pragma unroll
          for (int e = 0; e < 4; ++e) {
            const float cv = w0[e] * mp * (float)ap[e] + w1[e] * acc[mi][2 * pj][e] + w2[e] * mn * (float)an[e];
            y[e] = silu_f(cv) * acc[mi][2 * pj + 1][e];
          }
          *(h16x4*)(p.ACT + (size_t)R * DFF + j) = pack4(y[0], y[1], y[2], y[3]);
        }
      }
    }
  }
}

__device__ __forceinline__ void grid_bar(unsigned* ctr, unsigned target) {
  asm volatile("s_waitcnt vmcnt(0) lgkmcnt(0)" ::: "memory");
  __syncthreads();
  if (threadIdx.x == 0) {
    __builtin_amdgcn_fence(__ATOMIC_RELEASE, "agent");
    asm volatile("s_waitcnt vmcnt(0)" ::: "memory");
    __hip_atomic_fetch_add(ctr, 1u, __ATOMIC_RELAXED, __HIP_MEMORY_SCOPE_AGENT);
    while (__hip_atomic_load(ctr, __ATOMIC_RELAXED, __HIP_MEMORY_SCOPE_AGENT) < target) __builtin_amdgcn_s_sleep(2);
    __builtin_amdgcn_fence(__ATOMIC_ACQUIRE, "agent");
    asm volatile("s_waitcnt vmcnt(0)" ::: "memory");
  }
  __syncthreads();
}

__global__ void __launch_bounds__(NTHREADS, 2) mega_kernel(KArgs ka) {
  __shared__ __attribute__((aligned(1024))) unsigned char smem[LDS_BYTES];
  cg::grid_group grid = cg::this_grid();
  const Params p = make_params(ka);
  if (blockIdx.x == 0 && threadIdx.x < 8) __hip_atomic_store(p.bar + threadIdx.x * 16, 0u, __ATOMIC_RELAXED, __HIP_MEMORY_SCOPE_AGENT);
  unsigned nbar = 0;
  const unsigned G = gridDim.x;
#define GBAR() do { ++nbar; grid_bar(p.bar, nbar * G); } while (0)
  prep_phase(p, smem, p.bar + 16 * 5);
  grid.sync();
  norm_phase(p, 0, 0, true, NTOK);
  GBAR();
  for (int l = 0; l < 2; ++l) {
    const bool first = (l == 0);
    const int nrows = first ? NTOK : NLAT;
    p1_phase(p, l, smem);
    GBAR();
    p2_phase(p, l, smem, p.bar + 16 * (1 + l));
    GBAR();
    resid_gemm_phase(p, l, 0, first, nrows, smem);
    GBAR();
    norm_phase(p, l, 1, false, nrows);
    GBAR();
    p4_phase(p, l, nrows, smem);
    GBAR();
    resid_gemm_phase(p, l, 1, false, nrows, smem);
    GBAR();
    if (first) { norm_phase(p, 1, 0, false, NTOK); GBAR(); }
  }
  final_norm_phase(p);
}

extern "C" void kernel_launch(void* const* d_in, const int* in_sizes, int n_in, void* d_out, int out_size, void* d_ws,
                              size_t ws_size, hipStream_t stream) {
  static int grid_blocks = 0;
  if (!grid_blocks) {
    int dev = 0, cus = 0, per_cu = 0;
    (void)hipGetDevice(&dev);
    (void)hipDeviceGetAttribute(&cus, hipDeviceAttributeMultiprocessorCount, dev);
    (void)hipOccupancyMaxActiveBlocksPerMultiprocessor(&per_cu, mega_kernel, NTHREADS, 0);
    if (per_cu > 1) per_cu = 1;
    if (per_cu < 1) per_cu = 1;
    grid_blocks = cus * per_cu;
  }
  KArgs a{};
  for (int i = 0; i < 22; ++i) a.in[i] = (const float*)d_in[i];
  a.out = (float*)d_out;
  a.ws = (unsigned char*)d_ws;
  if (OFF_END > ws_size) fprintf(stderr, "workspace too small: need %zu have %zu\n", (size_t)OFF_END, ws_size);
  void* args[] = {&a};
  hipError_t e = hipLaunchCooperativeKernel((void*)mega_kernel, dim3(grid_blocks), dim3(NTHREADS), args, 0, stream);
  if (e != hipSuccess) fprintf(stderr, "cooperative launch failed: %s (grid %d)\n", hipGetErrorString(e), grid_blocks);
}
```
